# Optimizing an MI355X kernel written in HIP

```python
import jax, jax.numpy as jnp
from jax import lax
import numpy as np

D_MODEL = 1024
BATCH = 4
SEQ = 8192
DEPTH = 1

CHUNK = 64

A_HEADS = 8
A_HEAD_DIM = 64
A_WIDTH = A_HEADS * A_HEAD_DIM
A_LEFT_CHUNKS = 8
A_BAND = (A_LEFT_CHUNKS + 1) * CHUNK
REL_CLIP = 128

B_HEADS = 8
B_NOPE_DIM = 64
B_ROPE_DIM = 32
B_QK_DIM = B_NOPE_DIM + B_ROPE_DIM
B_V_DIM = 64
B_WIDTH = B_HEADS * B_V_DIM
Q_LORA = 256
KV_LORA = 128
ROPE_THETA = 10000.0
Q_BLOCK = 128

DEEPNORM_ALPHA = (2 * DEPTH) ** 0.25
DEEPNORM_BETA = (8 * DEPTH) ** -0.25
LN_EPS = 1e-5
RMS_EPS = 1e-6
NEG_INF = -1e30

IN_SPLITS = (A_WIDTH, A_WIDTH, A_WIDTH, A_WIDTH,
             Q_LORA, KV_LORA, B_ROPE_DIM, B_WIDTH,
             D_MODEL, D_MODEL)
IN_COLS = sum(IN_SPLITS)

kernel_name = "hybrid_chunk_relpos_mla_deepnorm"


def _split_points():
    pts, acc = [], 0
    for w in IN_SPLITS[:-1]:
        acc += w
        pts.append(acc)
    return pts


def layer_norm(x, g, b):
    xf = x.astype(jnp.float32)
    mu = jnp.mean(xf, axis=-1, keepdims=True)
    var = jnp.mean(jnp.square(xf - mu), axis=-1, keepdims=True)
    return ((xf - mu) * lax.rsqrt(var + LN_EPS) * g.astype(jnp.float32) + b.astype(jnp.float32)).astype(x.dtype)


def rms_norm(x, g):
    xf = x.astype(jnp.float32)
    return (xf * lax.rsqrt(jnp.mean(jnp.square(xf), axis=-1, keepdims=True) + RMS_EPS) * g.astype(jnp.float32)).astype(x.dtype)


def rope(x, positions):
    half = x.shape[-1] // 2
    inv_freq = ROPE_THETA ** (-jnp.arange(half, dtype=jnp.float32) / half)
    ang = positions.astype(jnp.float32)[..., None] * inv_freq
    cos = jnp.cos(ang)[:, :, None, :]
    sin = jnp.sin(ang)[:, :, None, :]
    x1 = x[..., :half].astype(jnp.float32)
    x2 = x[..., half:].astype(jnp.float32)
    return jnp.concatenate([x1 * cos - x2 * sin, x2 * cos + x1 * sin], axis=-1).astype(x.dtype)


def chunked_relpos_attention(q, k, v, rel_bias):
    B, S, H, Dh = q.shape
    n_chunks = S // CHUNK
    pad = A_LEFT_CHUNKS * CHUNK
    k_pad = jnp.pad(k, ((0, 0), (pad, 0), (0, 0), (0, 0)))
    v_pad = jnp.pad(v, ((0, 0), (pad, 0), (0, 0), (0, 0)))
    rel = jnp.clip(jnp.arange(CHUNK)[:, None] + pad - jnp.arange(A_BAND)[None, :], -REL_CLIP, REL_CLIP) + REL_CLIP
    bias = jnp.transpose(rel_bias[rel], (2, 0, 1)).astype(jnp.float32)
    scale = Dh ** -0.5

    def one_chunk(c):
        start = c * CHUNK
        qc = lax.dynamic_slice_in_dim(q, start, CHUNK, axis=1)
        kc = lax.dynamic_slice_in_dim(k_pad, start, A_BAND, axis=1)
        vc = lax.dynamic_slice_in_dim(v_pad, start, A_BAND, axis=1)
        s = jnp.einsum('bqhd,bkhd->bhqk', qc, kc).astype(jnp.float32) * scale + bias
        valid = (start - pad + jnp.arange(A_BAND)) >= 0
        s = jnp.where(valid[None, None, None, :], s, NEG_INF)
        p = jax.nn.softmax(s, axis=-1).astype(vc.dtype)
        return jnp.einsum('bhqk,bkhd->bqhd', p, vc)

    out = lax.map(one_chunk, jnp.arange(n_chunks))
    return jnp.transpose(out, (1, 0, 2, 3, 4)).reshape(B, S, H, Dh)


def chunk_causal_attention(q, k, v):
    B, S, H, Dqk = q.shape
    n_blocks = S // Q_BLOCK
    scale = Dqk ** -0.5
    key_chunk = jnp.arange(S) // CHUNK

    def one_block(i):
        start = i * Q_BLOCK
        qb = lax.dynamic_slice_in_dim(q, start, Q_BLOCK, axis=1)
        s = jnp.einsum('bqhd,bkhd->bhqk', qb, k).astype(jnp.float32) * scale
        q_chunk = (start + jnp.arange(Q_BLOCK)) // CHUNK
        mask = key_chunk[None, :] <= q_chunk[:, None]
        s = jnp.where(mask[None, None], s, NEG_INF)
        p = jax.nn.softmax(s, axis=-1).astype(v.dtype)
        return jnp.einsum('bhqk,bkhd->bqhd', p, v)

    out = lax.map(one_block, jnp.arange(n_blocks))
    return jnp.transpose(out, (1, 0, 2, 3, 4)).reshape(B, S, H, v.shape[-1])


def setup_inputs(seed: int = 0) -> dict:
    key = jax.random.key(seed)
    ks = jax.random.split(key, 16)
    f32 = jnp.float32
    nrm = lambda k, shape, s: jax.random.normal(k, shape, f32) * s
    return {
        "x": jax.random.normal(ks[0], (BATCH, SEQ, D_MODEL), f32),
        "positions": jnp.broadcast_to(jnp.arange(SEQ, dtype=jnp.int32), (BATCH, SEQ)),
        "ln_in_g": 1.0 + nrm(ks[1], (D_MODEL,), 0.01),
        "ln_in_b": nrm(ks[2], (D_MODEL,), 0.01),
        "w_in": nrm(ks[3], (DEPTH, D_MODEL, IN_COLS), D_MODEL ** -0.5),
        "b_in": nrm(ks[4], (DEPTH, IN_COLS), 0.01),
        "q_norm_g": 1.0 + nrm(ks[5], (DEPTH, Q_LORA), 0.01),
        "kv_norm_g": 1.0 + nrm(ks[6], (DEPTH, KV_LORA), 0.01),
        "w_uq": nrm(ks[7], (DEPTH, Q_LORA, B_HEADS * B_QK_DIM), Q_LORA ** -0.5),
        "w_ukv": nrm(ks[8], (DEPTH, KV_LORA, B_HEADS * (B_NOPE_DIM + B_V_DIM)), KV_LORA ** -0.5),
        "rel_bias": nrm(ks[9], (DEPTH, 2 * REL_CLIP + 1, A_HEADS), 0.2),
        "w_proj_a": nrm(ks[10], (DEPTH, A_WIDTH, D_MODEL), A_WIDTH ** -0.5 * DEEPNORM_BETA),
        "w_proj_b": nrm(ks[11], (DEPTH, B_WIDTH, D_MODEL), B_WIDTH ** -0.5 * DEEPNORM_BETA),
        "w_out": nrm(ks[12], (DEPTH, D_MODEL, D_MODEL), D_MODEL ** -0.5 * DEEPNORM_BETA),
        "ln_post_g": 1.0 + nrm(ks[13], (DEPTH, D_MODEL), 0.01),
        "ln_post_b": nrm(ks[14], (DEPTH, D_MODEL), 0.01),
    }


def reference(x, positions, ln_in_g, ln_in_b, w_in, b_in, q_norm_g, kv_norm_g, w_uq, w_ukv,
              rel_bias, w_proj_a, w_proj_b, w_out, ln_post_g, ln_post_b):
    B, S, _ = x.shape
    h = layer_norm(x, ln_in_g, ln_in_b)
    pts = _split_points()
    for l in range(DEPTH):
        proj = h @ w_in[l] + b_in[l]
        a_q, a_k, a_v, a_z, b_cq, b_ckv, b_kr, b_z, g_a, g_b = jnp.split(proj, pts, axis=-1)

        ya = chunked_relpos_attention(a_q.reshape(B, S, A_HEADS, A_HEAD_DIM),
                                      a_k.reshape(B, S, A_HEADS, A_HEAD_DIM),
                                      a_v.reshape(B, S, A_HEADS, A_HEAD_DIM), rel_bias[l])
        ya = (ya.reshape(B, S, A_WIDTH) * jax.nn.silu(a_z)) @ w_proj_a[l]

        cq = rms_norm(b_cq, q_norm_g[l])
        qb = (cq @ w_uq[l]).reshape(B, S, B_HEADS, B_QK_DIM)
        q_full = jnp.concatenate([qb[..., :B_NOPE_DIM], rope(qb[..., B_NOPE_DIM:], positions)], axis=-1)
        ckv = rms_norm(b_ckv, kv_norm_g[l])
        kv = (ckv @ w_ukv[l]).reshape(B, S, B_HEADS, B_NOPE_DIM + B_V_DIM)
        k_pe = rope(b_kr[:, :, None, :], positions)
        k_full = jnp.concatenate([kv[..., :B_NOPE_DIM],
                                  jnp.broadcast_to(k_pe, (B, S, B_HEADS, B_ROPE_DIM))], axis=-1)
        yb = chunk_causal_attention(q_full, k_full, kv[..., B_NOPE_DIM:])
        yb = (yb.reshape(B, S, B_WIDTH) * jax.nn.silu(b_z)) @ w_proj_b[l]

        mixed = jax.nn.sigmoid(g_a) * ya + jax.nn.sigmoid(g_b) * yb
        out = mixed @ w_out[l]
        h = layer_norm(DEEPNORM_ALPHA * h + out, ln_post_g[l], ln_post_b[l])
    return h
```

```cpp
#include <hip/hip_runtime.h>
#include <hip/hip_cooperative_groups.h>
#include <cstdio>
#include <cstdint>
namespace cg = cooperative_groups;

#ifndef ONE_LAUNCH
#define ONE_LAUNCH 1
#endif

#define LAS __attribute__((address_space(3)))
typedef unsigned short bf16_t;
typedef short bf16x8 __attribute__((ext_vector_type(8)));
typedef short s16x4 __attribute__((ext_vector_type(4)));
typedef float f32x2 __attribute__((ext_vector_type(2)));
typedef float f32x4 __attribute__((ext_vector_type(4)));
typedef float f32x16 __attribute__((ext_vector_type(16)));
typedef unsigned u32x2 __attribute__((ext_vector_type(2)));
typedef unsigned u32x4 __attribute__((ext_vector_type(4)));

constexpr int NTOK = 32768, DMOD = 1024, SEQ = 8192;
constexpr int INC = 5024, INCP = 5120;
constexpr int C_AQ = 0, C_AK = 512, C_AV = 1024, C_AZ = 1536, C_CQ = 2048, C_CKV = 2304, C_KR = 2432, C_BZ = 2560, C_GA = 3072, C_GB = 4096;
constexpr float LOG2E = 1.4426950408889634f;
constexpr float C2A = 0.125f * LOG2E;
constexpr float C2B = 0.10206207261596575f * LOG2E;
constexpr float ALPHA = 1.189207115002721f;
constexpr float LN_EPS = 1e-5f, RMS_EPS = 1e-6f;

constexpr size_t MiB = 1u << 20;
constexpr size_t WS_BIAS = 1 * MiB;
constexpr size_t WS_STAT = 2 * MiB;
constexpr size_t WS_RS = 2 * MiB + 512 * 1024;
constexpr size_t WS_WUQ = 3 * MiB;
constexpr size_t WS_WUKV = 3 * MiB + 512 * 1024;
constexpr size_t WS_WP = 4 * MiB;
constexpr size_t WS_WOUT = 6 * MiB;
constexpr size_t WS_CS = 8 * MiB;
constexpr size_t WS_WIN = 12 * MiB;
constexpr size_t WS_KPE = 22 * MiB;
constexpr size_t WS_HB = 24 * MiB;
constexpr size_t WS_QB = 24 * MiB;
constexpr size_t WS_KB = 88 * MiB;
constexpr size_t WS_VB = 120 * MiB;
constexpr size_t WS_MIX = 88 * MiB;
constexpr size_t WS_PROJ = 152 * MiB;
constexpr size_t WS_END = 472 * MiB;

__device__ __forceinline__ unsigned cvt_pk_bf16(float lo, float hi) { unsigned r; asm volatile("v_cvt_pk_bf16_f32 %0, %1, %2" : "=v"(r) : "v"(lo), "v"(hi)); return r; }
__device__ __forceinline__ float bf_lo(unsigned w) { return __uint_as_float(w << 16); }
__device__ __forceinline__ float bf_hi(unsigned w) { return __uint_as_float(w & 0xffff0000u); }
__device__ __forceinline__ float bf1(bf16_t b) { return __uint_as_float(((unsigned)b) << 16); }
__device__ __forceinline__ float wave_sum(float v) {
#pragma unroll
    for (int o = 1; o < 64; o <<= 1) v += __shfl_xor(v, o);
    return v;
}
__device__ __forceinline__ float sigmoidf_(float x) { return __builtin_amdgcn_rcpf(1.0f + __builtin_amdgcn_exp2f(-x * LOG2E)); }
#define LDS_WAIT() asm volatile("s_waitcnt lgkmcnt(0)" ::: "memory")

namespace pg8 {
constexpr int BM = 256, BK = 64, HALF = 128, HTB = HALF * BK * 2, STAGE_BYTES = 8 * HTB, NXCD = 8, WGM = 8;
__host__ __device__ __forceinline__ int lds_byte(int r, int c) { const int st = (r >> 4) * 2 + (c >> 5), rr = r & 15, cc = c & 31, ob = rr * 64 + cc * 2; return st * 1024 + (ob ^ (((ob >> 9) & 1) << 5)); }
__host__ __device__ __forceinline__ void stage_rc(int b, int& R, int& C) { const int st = b / 1024, sb = b % 1024, swz = sb ^ (((sb >> 9) & 1) << 5); R = (st >> 1) * 16 + swz / 64; C = (st & 1) * 32 + (swz % 64) / 2; }
__host__ __device__ __forceinline__ int perm32(int rho) { const int n = rho >> 4, i = rho & 15; return 8 * (i >> 2) + 4 * n + (i & 3); }

struct Unit { int pm, pn; };
struct Gemm { const bf16_t* A; const bf16_t* Bt; int M, N, K, lda, ldb; };

struct StaticOrder {
    int nM, nN, nwg, G, c;
    __device__ void init(int M, int N, int G_, int c_) { nM = M / BM; nN = N / BM; nwg = nM * nN; G = G_; c = c_; }
    __device__ bool next(int i, Unit& u) const {
        const long L = (long)i * G + c; if (L >= nwg) return false;
        int wgid = (int)L; { const int q = nwg / NXCD, r = nwg % NXCD, xcd = wgid % NXCD, off = wgid / NXCD; wgid = (xcd < r ? xcd * (q + 1) : r * (q + 1) + (xcd - r) * q) + off; }
        const int nig = WGM * nN, gid = wgid / nig, fm = gid * WGM, gsz = (nM - fm) < WGM ? (nM - fm) : WGM;
        u.pm = fm + ((wgid % nig) % gsz); u.pn = (wgid % nig) / gsz; return true;
    }
};

typedef f32x4 Acc[2][2][4][2];

struct EpiProj {
    static constexpr bool PERM = true; static constexpr int MID_T = -1;
    bf16_t* O; const float* bias;
    __device__ __forceinline__ void mid(Acc&, const Unit&, int, int, int, int) const {}
    __device__ __forceinline__ void operator()(const Acc& acc, const Unit& u, int wr, int wc, int fr, int fq) const {
        const int row0 = u.pm * BM + wr * 64 + fr; const int col0 = u.pn * BM + wc * 32 + 8 * fq;
        const float sc = (u.pn < 2) ? C2A : 1.0f;
        const int actm = (u.pn >= 12) ? 2 : ((u.pn == 6 || u.pn == 7 || u.pn == 10 || u.pn == 11) ? 1 : 0);
        f32x4 bv[2][2];
#pragma unroll
        for (int bj = 0; bj < 2; ++bj)
#pragma unroll
            for (int n = 0; n < 2; ++n) bv[bj][n] = *(const f32x4*)(bias + col0 + bj * HALF + 4 * n);
#pragma unroll
        for (int ai = 0; ai < 2; ++ai)
#pragma unroll
            for (int m = 0; m < 4; ++m) { bf16_t* rowp = O + (size_t)(row0 + ai * HALF + m * 16) * INCP + col0;
#pragma unroll
                for (int bj = 0; bj < 2; ++bj) { f32x4 v0 = (acc[ai][bj][m][0] + bv[bj][0]) * sc, v1 = (acc[ai][bj][m][1] + bv[bj][1]) * sc;
                    if (actm) {
#pragma unroll
                        for (int j = 0; j < 4; ++j) { const float s0 = sigmoidf_(v0[j]), s1 = sigmoidf_(v1[j]); v0[j] = (actm == 2) ? s0 : v0[j] * s0; v1[j] = (actm == 2) ? s1 : v1[j] * s1; } }
                    u32x4 w; w.x = cvt_pk_bf16(v0[0], v0[1]); w.y = cvt_pk_bf16(v0[2], v0[3]); w.z = cvt_pk_bf16(v1[0], v1[1]); w.w = cvt_pk_bf16(v1[2], v1[3]);
                    *(u32x4*)(rowp + bj * HALF) = w; } }
    }
};
struct EpiKV {
    static constexpr bool PERM = true; static constexpr int MID_T = -1;
    bf16_t* KBp; bf16_t* VBp; const float* rs;
    __device__ __forceinline__ void mid(Acc&, const Unit&, int, int, int, int) const {}
    __device__ __forceinline__ void operator()(const Acc& acc, const Unit& u, int wr, int wc, int fr, int fq) const {
        const int row0 = u.pm * BM + wr * 64 + fr; int colt = u.pn * BM; bf16_t* base = KBp; if (colt >= 512) { base = VBp; colt -= 512; }
        const int col0 = colt + wc * 32 + 8 * fq;
#pragma unroll
        for (int ai = 0; ai < 2; ++ai)
#pragma unroll
            for (int m = 0; m < 4; ++m) { const int row = row0 + ai * HALF + m * 16; bf16_t* rowp = base + (size_t)row * 512 + col0;
#pragma unroll
                for (int bj = 0; bj < 2; ++bj) { const f32x4 v0 = acc[ai][bj][m][0], v1 = acc[ai][bj][m][1];
                    u32x4 w; w.x = cvt_pk_bf16(v0[0], v0[1]); w.y = cvt_pk_bf16(v0[2], v0[3]); w.z = cvt_pk_bf16(v1[0], v1[1]); w.w = cvt_pk_bf16(v1[2], v1[3]);
                    *(u32x4*)(rowp + bj * HALF) = w; } }
    }
};
struct EpiQ {
    static constexpr bool PERM = false; static constexpr int MID_T = -1;
    bf16_t* QBp; const float* rs; const float* cs;
    __device__ __forceinline__ void mid(Acc&, const Unit&, int, int, int, int) const {}
    __device__ __forceinline__ void operator()(const Acc& acc, const Unit& u, int wr, int wc, int fr, int fq) const {
        const int row0 = u.pm * BM + wr * 64 + fr;
#pragma unroll
        for (int bj = 0; bj < 2; ++bj) { const int cb = u.pn * BM + bj * HALF + wc * 32; const bool rope = ((cb >> 5) % 3) == 2;
#pragma unroll
            for (int ai = 0; ai < 2; ++ai)
#pragma unroll
                for (int m = 0; m < 4; ++m) { const int row = row0 + ai * HALF + m * 16;
                    f32x4 x1 = acc[ai][bj][m][0] * C2B, x2 = acc[ai][bj][m][1] * C2B;
                    if (rope) { const f32x4 cv = *(const f32x4*)(cs + (size_t)row * 32 + 4 * fq), sv = *(const f32x4*)(cs + (size_t)row * 32 + 16 + 4 * fq);
                        const f32x4 o1 = x1 * cv - x2 * sv, o2 = x2 * cv + x1 * sv; x1 = o1; x2 = o2; }
                    u32x2 w1, w2; w1.x = cvt_pk_bf16(x1[0], x1[1]); w1.y = cvt_pk_bf16(x1[2], x1[3]); w2.x = cvt_pk_bf16(x2[0], x2[1]); w2.y = cvt_pk_bf16(x2[2], x2[3]);
                    bf16_t* p = QBp + (size_t)row * 768 + cb + 4 * fq;
                    *(u32x2*)p = w1; *(u32x2*)(p + 16) = w2;
                    asm volatile("" ::: "memory"); } }
    }
};
template <int SECOND> struct EpiMix {
    static constexpr bool PERM = true; static constexpr int MID_T = -1;
    bf16_t* MIXp; const bf16_t* PROJp;
    __device__ __forceinline__ void mid(Acc&, const Unit&, int, int, int, int) const {}
    __device__ __forceinline__ void operator()(const Acc& acc, const Unit& u, int wr, int wc, int fr, int fq) const {
        const int row0 = u.pm * BM + wr * 64 + fr; const int col0 = u.pn * BM + wc * 32 + 8 * fq;
#pragma unroll
        for (int ai = 0; ai < 2; ++ai)
#pragma unroll
            for (int m = 0; m < 4; ++m) { const size_t row = (size_t)(row0 + ai * HALF + m * 16); const bf16_t* rowp = PROJp + row * INCP + col0 + (SECOND ? C_GB : C_GA);
#pragma unroll
                for (int bj = 0; bj < 2; ++bj) { const u32x4 gt = *(const u32x4*)(rowp + bj * HALF); u32x4 pv = (u32x4){0u, 0u, 0u, 0u};
                    if (SECOND) pv = *(const u32x4*)(MIXp + row * DMOD + col0 + bj * HALF);
                    float o[8];
#pragma unroll
                    for (int j = 0; j < 4; ++j) { o[2 * j] = bf_lo(pv[j]) + acc[ai][bj][m][j >> 1][(j & 1) * 2] * bf_lo(gt[j]); o[2 * j + 1] = bf_hi(pv[j]) + acc[ai][bj][m][j >> 1][(j & 1) * 2 + 1] * bf_hi(gt[j]); }
                    u32x4 w; w.x = cvt_pk_bf16(o[0], o[1]); w.y = cvt_pk_bf16(o[2], o[3]); w.z = cvt_pk_bf16(o[4], o[5]); w.w = cvt_pk_bf16(o[6], o[7]);
                    *(u32x4*)(MIXp + row * DMOD + col0 + bj * HALF) = w; }
                asm volatile("" ::: "memory"); }
    }
};
struct EpiOut {
    static constexpr bool PERM = false; static constexpr int MID_T = -1;
    float* Y; const float* X; const float* stat; const float* g; const float* b;
    __device__ __forceinline__ void mid(Acc&, const Unit&, int, int, int, int) const {}
    __device__ __forceinline__ void operator()(const Acc& acc, const Unit& u, int wr, int wc, int fr, int fq) const {
        const int row0 = u.pm * BM + wr * 64 + fr; const int col0 = u.pn * BM + wc * 32 + 4 * fq;
        f32x4 gv[2][2], bv[2][2];
#pragma unroll
        for (int bj = 0; bj < 2; ++bj)
#pragma unroll
            for (int n = 0; n < 2; ++n) { gv[bj][n] = *(const f32x4*)(g + col0 + bj * HALF + n * 16) * ALPHA; bv[bj][n] = *(const f32x4*)(b + col0 + bj * HALF + n * 16) * ALPHA; }
#pragma unroll
        for (int ai = 0; ai < 2; ++ai)
#pragma unroll
            for (int m = 0; m < 4; ++m) { const size_t row = (size_t)(row0 + ai * HALF + m * 16); const f32x2 st = *(const f32x2*)(stat + 2 * row); const size_t off = row * DMOD + col0;
#pragma unroll
                for (int bj = 0; bj < 2; ++bj)
#pragma unroll
                    for (int n = 0; n < 2; ++n) { const f32x4 xv = *(const f32x4*)(X + off + bj * HALF + n * 16);
                        const f32x4 o = ((xv - st.x) * st.y) * gv[bj][n] + bv[bj][n] + acc[ai][bj][m][n];
                        *(f32x4*)(Y + off + bj * HALF + n * 16) = o; }
                asm volatile("" ::: "memory"); }
    }
};

template <class Epi, bool ALIGN_EPI = true, bool SP2 = true>
__device__ __forceinline__ void gemm_phase(LAS unsigned char* lds, const Gemm g, const StaticOrder& S, const Epi& E) {
    const int tid = threadIdx.x, wid = __builtin_amdgcn_readfirstlane(tid >> 6), lane = tid & 63, wr = wid >> 2, wc = wid & 3, fr = lane & 15, fq = lane >> 4;
    const int K = g.K, nt = K / BK;
    unsigned voffA[2], voffB[2];
#pragma unroll
    for (int i = 0; i < 2; ++i) { int R, C; stage_rc(tid * 16 + i * 8192, R, C); const int Rb = Epi::PERM ? ((R & ~31) + perm32(R & 31)) : R;
        voffA[i] = (unsigned)(R * g.lda + C) * 2u; voffB[i] = (unsigned)(Rb * g.ldb + C) * 2u; }
    const size_t kstep = (size_t)(BK * 2);
    const size_t hsA = (size_t)HALF * g.lda * 2, hsB = (size_t)HALF * g.ldb * 2;
    const size_t tsA = 2 * hsA, tsB = 2 * hsB;
    const unsigned ldsw = (unsigned)wid * 1024u;
    const int aoff = lds_byte(wr * 64 + fr, fq * 8), boff = lds_byte(wc * 32 + fr, fq * 8);
#define PG8_SA(b, h) (((b) * 2 + (h)) * HTB)
#define PG8_SB(b, h) ((4 + (b) * 2 + (h)) * HTB)
#define PG8_STAGE(bufoff, gbase, voff) do { _Pragma("unroll") for (int _i = 0; _i < 2; ++_i) \
        __builtin_amdgcn_global_load_lds((const unsigned*)((const char*)(gbase) + (voff)[_i]), (LAS unsigned*)(lds + (bufoff) + ldsw + _i * 8192), 16, 0, 0); } while (0)
#define PG8_LDA(dst, b, h) do { _Pragma("unroll") for (int m = 0; m < 4; ++m) _Pragma("unroll") for (int k = 0; k < 2; ++k) dst[m][k] = *(const LAS bf16x8*)(lds + PG8_SA(b, h) + aoff + m * 2048 + k * 1024); } while (0)
#define PG8_LDB(dst, b, h) do { _Pragma("unroll") for (int n = 0; n < 2; ++n) _Pragma("unroll") for (int k = 0; k < 2; ++k) dst[n][k] = *(const LAS bf16x8*)(lds + PG8_SB(b, h) + boff + n * 2048 + k * 1024); } while (0)
#define PG8_MMA(ai, bj, At, Bt) do { __builtin_amdgcn_s_setprio(1); _Pragma("unroll") for (int m = 0; m < 4; ++m) _Pragma("unroll") for (int n = 0; n < 2; ++n) _Pragma("unroll") for (int k = 0; k < 2; ++k) \
        acc[ai][bj][m][n] = __builtin_amdgcn_mfma_f32_16x16x32_bf16(Bt[n][k], At[m][k], acc[ai][bj][m][n], 0, 0, 0); __builtin_amdgcn_s_setprio(0); } while (0)
#define PG8_WAIT_V(n) asm volatile("s_waitcnt vmcnt(" #n ")" ::: "memory")
#define PG8_WAIT_L(n) asm volatile("s_waitcnt lgkmcnt(" #n ")" ::: "memory")
#define PG8_BAR __builtin_amdgcn_s_barrier()
#define PG8_SCHED __builtin_amdgcn_sched_barrier(0)
    Unit cur, nxt; int ui = 0;
    if (!S.next(0, cur)) return;
    Acc acc;
#pragma unroll
    for (int a = 0; a < 2; ++a)
#pragma unroll
        for (int b = 0; b < 2; ++b)
#pragma unroll
            for (int m = 0; m < 4; ++m)
#pragma unroll
                for (int n = 0; n < 2; ++n) acc[a][b][m][n] = (f32x4){0.f, 0.f, 0.f, 0.f};
    bf16x8 At[4][2], B0[2][2], B1[2][2];
    const char* cA = (const char*)g.A + (size_t)cur.pm * tsA; const char* cB = (const char*)g.Bt + (size_t)cur.pn * tsB;
    if constexpr (SP2) {
        PG8_STAGE(PG8_SB(0, 0), cB, voffB); PG8_STAGE(PG8_SB(0, 1), cB + hsB, voffB); PG8_STAGE(PG8_SA(0, 0), cA, voffA); PG8_STAGE(PG8_SA(0, 1), cA + hsA, voffA);
        if (wr == 1) PG8_BAR;
        PG8_WAIT_V(2); PG8_BAR;
        PG8_STAGE(PG8_SB(1, 0), cB + kstep, voffB); PG8_STAGE(PG8_SA(1, 0), cA + kstep, voffA); PG8_STAGE(PG8_SB(1, 1), cB + hsB + kstep, voffB);
        PG8_WAIT_V(6); PG8_BAR;
    }
    for (;;) {
        const bool has_next = S.next(ui + 1, nxt);
        const char* nA = has_next ? (const char*)g.A + (size_t)nxt.pm * tsA : cA; const char* nB = has_next ? (const char*)g.Bt + (size_t)nxt.pn * tsB : cB;
#pragma unroll 1
        for (int t = 0; t < nt; t += 2) {
            const bool last = (t == nt - 2);
            const char* a1 = cA + (size_t)(t + 1) * kstep;
            const char* a2 = last ? nA : cA + (size_t)(t + 2) * kstep; const char* b2 = last ? nB : cB + (size_t)(t + 2) * kstep;
            const char* a3 = a2 + kstep; const char* b3 = b2 + kstep;
            if constexpr (Epi::MID_T >= 0) { if (t == Epi::MID_T) E.mid(acc, cur, wr, wc, fr, fq); }
            PG8_LDB(B0, 0, 0); PG8_LDB(B1, 0, 1); PG8_SCHED; PG8_LDA(At, 0, 0); PG8_STAGE(PG8_SA(1, 1), a1 + hsA, voffA);
            PG8_WAIT_V(8); PG8_WAIT_L(0); PG8_BAR; PG8_MMA(0, 0, At, B0); PG8_MMA(0, 1, At, B1); PG8_BAR; PG8_SCHED;
            PG8_LDA(At, 0, 1); PG8_STAGE(PG8_SB(0, 0), b2, voffB); PG8_STAGE(PG8_SB(0, 1), b2 + hsB, voffB); PG8_STAGE(PG8_SA(0, 0), a2, voffA);
            PG8_WAIT_V(8); PG8_WAIT_L(0); PG8_BAR; PG8_MMA(1, 0, At, B0); PG8_MMA(1, 1, At, B1); PG8_BAR; PG8_SCHED;
            PG8_LDB(B0, 1, 0); PG8_LDB(B1, 1, 1); PG8_SCHED; PG8_LDA(At, 1, 0); PG8_STAGE(PG8_SA(0, 1), a2 + hsA, voffA);
            PG8_WAIT_V(8); PG8_WAIT_L(0); PG8_BAR; PG8_MMA(0, 0, At, B0); PG8_MMA(0, 1, At, B1); PG8_BAR; PG8_SCHED;
            PG8_LDA(At, 1, 1); PG8_STAGE(PG8_SB(1, 0), b3, voffB); PG8_STAGE(PG8_SB(1, 1), b3 + hsB, voffB); PG8_STAGE(PG8_SA(1, 0), a3, voffA);
            PG8_WAIT_V(8); PG8_WAIT_L(0); PG8_BAR; PG8_MMA(1, 0, At, B0); PG8_MMA(1, 1, At, B1); PG8_BAR; PG8_SCHED;
        }
        if constexpr (ALIGN_EPI) { if (wr == 0) PG8_BAR; }
        E(acc, cur, wr, wc, fr, fq);
        if (!has_next) break;
#pragma unroll
        for (int a = 0; a < 2; ++a)
#pragma unroll
            for (int b = 0; b < 2; ++b)
#pragma unroll
                for (int m = 0; m < 4; ++m)
#pragma unroll
                    for (int n = 0; n < 2; ++n) acc[a][b][m][n] = (f32x4){0.f, 0.f, 0.f, 0.f};
        cur = nxt; cA = nA; cB = nB; ++ui;
        if constexpr (ALIGN_EPI) { if (wr == 1) PG8_BAR; }
    }
    PG8_WAIT_V(0);
    if constexpr (!ALIGN_EPI) { if (wr == 0) PG8_BAR; }
    PG8_BAR;
#undef PG8_SA
#undef PG8_SB
#undef PG8_STAGE
#undef PG8_LDA
#undef PG8_LDB
#undef PG8_MMA
#undef PG8_WAIT_V
#undef PG8_WAIT_L
#undef PG8_BAR
#undef PG8_SCHED
}
}

namespace att {
constexpr int KOFF = 0, KSLOT = 12288, VOFF = 24576, VSLOT = 8192, WSF = 40960, OST = 43008, TAB = 75776, LDS_END = 77824;
constexpr float THR = 8.0f;
__device__ __forceinline__ int crow(int r, int hi) { return (r & 3) + 8 * (r >> 2) + 4 * hi; }
typedef short v4i16_t __attribute__((ext_vector_type(4)));
__device__ __forceinline__ s16x4 vtr(const LAS char* p) { return __builtin_bit_cast(s16x4, __builtin_amdgcn_ds_read_tr16_b64_v4i16((LAS v4i16_t*)p)); }

struct Ptrs { const bf16_t* PROJ; const bf16_t* QB; const bf16_t* KB; const bf16_t* VB; const bf16_t* KPE; bf16_t* YAB; const float* relb; };

template <int MODE>
__device__ __forceinline__ void attn_unit(LAS char* lds, int b, int h, int qb, const Ptrs& P) {
    constexpr int ND0 = MODE ? 6 : 4;
    const int tid = threadIdx.x, lane = tid & 63, r32 = lane & 31, hi = lane >> 5; const int wid = __builtin_amdgcn_readfirstlane(tid >> 6);
    const size_t rowbase = (size_t)b * SEQ; const int q0 = qb * 256;
    const size_t qrow = rowbase + q0 + wid * 32 + r32;
    const bf16_t* Qp = MODE ? (P.QB + qrow * 768 + h * 96) : (P.PROJ + qrow * INCP + C_AQ + h * 64);
    bf16x8 qr[ND0];
#pragma unroll
    for (int d0 = 0; d0 < ND0; ++d0) qr[d0] = *(const bf16x8*)(Qp + d0 * 16 + hi * 8);
    const int cw = 4 * qb + (wid >> 1);
    const int t_first = MODE ? 0 : ((4 * qb - 8) > 0 ? (4 * qb - 8) : 0), t_last = 4 * qb + 3;
    const int skey = tid >> 3, sc = tid & 7;
    const size_t ldk = MODE ? 512 : INCP;
    const bf16_t* ksrc = MODE ? (P.KB + (rowbase + skey) * 512 + h * 64 + sc * 8) : (P.PROJ + (rowbase + skey) * INCP + C_AK + h * 64 + sc * 8);
    const bf16_t* vsrc = MODE ? (P.VB + (rowbase + skey) * 512 + h * 64 + sc * 8) : (P.PROJ + (rowbase + skey) * INCP + C_AV + h * 64 + sc * 8);
    const bf16_t* psrc = P.KPE + (rowbase + (tid >> 2)) * 32 + (tid & 3) * 8;
    const int kdst = sc * 1024 + skey * 16, vdst = (sc >> 2) * 4096 + skey * 64 + (sc & 3) * 16, pdst = (8 + (tid & 3)) * 1024 + (tid >> 2) * 16;
    LAS float* wsf = (LAS float*)(lds + WSF + wid * 256);
    LAS float* tab = (LAS float*)(lds + TAB);
    if (MODE == 0) { if (tid < 257) tab[tid] = P.relb[tid * 8 + h] * LOG2E; }
    u32x4 rk, rv, rp;
#define ATT_LOAD(t) do { rk = *(const u32x4*)(ksrc + (size_t)(t) * 64 * ldk); rv = *(const u32x4*)(vsrc + (size_t)(t) * 64 * ldk); \
        if (MODE == 1) { if (tid < 256) rp = *(const u32x4*)(psrc + (size_t)(t) * 64 * 32); } } while (0)
#define ATT_STORE(buf) do { *(LAS u32x4*)(lds + KOFF + (buf) * KSLOT + kdst) = rk; *(LAS u32x4*)(lds + VOFF + (buf) * VSLOT + vdst) = rv; \
        if (MODE == 1) { if (tid < 256) *(LAS u32x4*)(lds + KOFF + (buf) * KSLOT + pdst) = rp; } } while (0)
    ATT_LOAD(t_first); ATT_STORE(0);
    __syncthreads();
    float m_run = 0.f, l_run = 0.f; bool first = true;
    f32x16 o0, o1;
#pragma unroll
    for (int r = 0; r < 16; ++r) { o0[r] = 0.f; o1[r] = 0.f; }
    const int ql = (wid & 1) * 32 + r32;
    for (int t = t_first; t <= t_last; ++t) {
        const int buf = (t - t_first) & 1;
        if (t < t_last) ATT_LOAD(t + 1);
        const bool act = MODE ? (t <= cw) : (t <= cw && t >= cw - 8);
        if (act) {
            f32x16 p0, p1; const float nm = -m_run;
            if (MODE == 0) {
                const int dt = cw - t;
                if (dt >= 3) { const float bc = tab[256];
#pragma unroll
                    for (int r = 0; r < 16; ++r) { p0[r] = nm + bc; p1[r] = p0[r]; } }
                else {
#pragma unroll
                    for (int r = 0; r < 16; ++r) { const int d0_ = 64 * dt + ql - crow(r, hi); const int i0 = (d0_ < 128 ? d0_ : 128) + 128; const int d1_ = d0_ - 32; const int i1 = (d1_ < 128 ? d1_ : 128) + 128;
                        p0[r] = nm + tab[i0]; p1[r] = nm + tab[i1]; } }
            } else {
#pragma unroll
                for (int r = 0; r < 16; ++r) { p0[r] = nm; p1[r] = nm; } }
            const LAS char* kb = lds + KOFF + buf * KSLOT + hi * 1024 + r32 * 16;
#pragma unroll
            for (int d0 = 0; d0 < ND0; ++d0) {
                const bf16x8 a0 = *(const LAS bf16x8*)(kb + d0 * 2048), a1 = *(const LAS bf16x8*)(kb + d0 * 2048 + 512);
                p0 = __builtin_amdgcn_mfma_f32_32x32x16_bf16(a0, qr[d0], p0, 0, 0, 0);
                p1 = __builtin_amdgcn_mfma_f32_32x32x16_bf16(a1, qr[d0], p1, 0, 0, 0);
            }
            float rm = fmaxf(p0[0], p1[0]);
#pragma unroll
            for (int r = 1; r < 16; ++r) rm = fmaxf(rm, fmaxf(p0[r], p1[r]));
            rm = fmaxf(rm, __shfl_xor(rm, 32));
            if (first) {
                m_run += rm;
#pragma unroll
                for (int r = 0; r < 16; ++r) { p0[r] -= rm; p1[r] -= rm; }
                first = false;
            } else if (__any(rm > THR)) {
                const float dl = fmaxf(rm, 0.f); m_run += dl;
#pragma unroll
                for (int r = 0; r < 16; ++r) { p0[r] -= dl; p1[r] -= dl; }
                const float f = __builtin_amdgcn_exp2f(-dl); l_run *= f;
                if (hi == 0) wsf[r32] = f;
                LDS_WAIT();
#pragma unroll
                for (int r = 0; r < 16; ++r) { const float fr_ = wsf[crow(r, hi)]; o0[r] *= fr_; o1[r] *= fr_; }
            }
            float s = 0.f;
#pragma unroll
            for (int r = 0; r < 16; ++r) { p0[r] = __builtin_amdgcn_exp2f(p0[r]); p1[r] = __builtin_amdgcn_exp2f(p1[r]); s += p0[r] + p1[r]; }
            l_run += s;
            u32x4 pw[4];
#pragma unroll
            for (int j = 0; j < 4; ++j) { pw[0][j] = cvt_pk_bf16(p0[2 * j], p0[2 * j + 1]); pw[1][j] = cvt_pk_bf16(p0[8 + 2 * j], p0[9 + 2 * j]);
                pw[2][j] = cvt_pk_bf16(p1[2 * j], p1[2 * j + 1]); pw[3][j] = cvt_pk_bf16(p1[8 + 2 * j], p1[9 + 2 * j]); }
            const LAS char* vp = lds + VOFF + buf * VSLOT + ((lane >> 4) & 1) * 32 + (lane & 3) * 8 + (4 * hi + ((lane & 15) >> 2)) * 64;
#pragma unroll
            for (int ks = 0; ks < 4; ++ks) {
                const s16x4 l0 = vtr(vp + ks * 1024), h0 = vtr(vp + ks * 1024 + 512), l1 = vtr(vp + 4096 + ks * 1024), h1 = vtr(vp + 4096 + ks * 1024 + 512);
                const bf16x8 b0 = (bf16x8){l0[0], l0[1], l0[2], l0[3], h0[0], h0[1], h0[2], h0[3]}, b1 = (bf16x8){l1[0], l1[1], l1[2], l1[3], h1[0], h1[1], h1[2], h1[3]};
                const bf16x8 pa = __builtin_bit_cast(bf16x8, pw[ks]);
                o0 = __builtin_amdgcn_mfma_f32_32x32x16_bf16(pa, b0, o0, 0, 0, 0);
                o1 = __builtin_amdgcn_mfma_f32_32x32x16_bf16(pa, b1, o1, 0, 0, 0);
            }
        }
        if (t < t_last) ATT_STORE(buf ^ 1);
        __syncthreads();
    }
#undef ATT_LOAD
#undef ATT_STORE
    float lt = l_run + __shfl_xor(l_run, 32);
    if (hi == 0) wsf[32 + r32] = lt;
    LDS_WAIT();
    LAS bf16_t* stg = (LAS bf16_t*)(lds + OST + wid * 4096);
#pragma unroll
    for (int r = 0; r < 16; ++r) { const int orow = crow(r, hi); const float rl = 1.0f / wsf[32 + orow];
        stg[orow * 64 + r32] = (bf16_t)(cvt_pk_bf16(o0[r] * rl, 0.f) & 0xffffu); stg[orow * 64 + 32 + r32] = (bf16_t)(cvt_pk_bf16(o1[r] * rl, 0.f) & 0xffffu); }
    LDS_WAIT();
    const int zc = MODE ? C_BZ : C_AZ;
#pragma unroll
    for (int i = 0; i < 4; ++i) { const int row = i * 8 + (lane >> 3), ch = lane & 7; const u32x4 v = *(const LAS u32x4*)(stg + row * 64 + ch * 8);
        const size_t grow = rowbase + q0 + wid * 32 + row;
        const u32x4 z = *(const u32x4*)(P.PROJ + grow * INCP + zc + h * 64 + ch * 8); u32x4 w;
#pragma unroll
        for (int j = 0; j < 4; ++j) w[j] = cvt_pk_bf16(bf_lo(v[j]) * bf_lo(z[j]), bf_hi(v[j]) * bf_hi(z[j]));
        *(u32x4*)(P.YAB + grow * DMOD + (MODE ? 512 : 0) + h * 64 + ch * 8) = w; }
    __syncthreads();
}
}

template <int MAP>
__device__ __forceinline__ void tr_item(const float* W, int N, bf16_t* WT, int ldt, int coff, const float* gain, LAS float* scr, int item, int lane) {
    const int nblk = N / 32, kb = item / nblk, nb = item % nblk, k0 = 64 * kb, n0 = 32 * nb;
#pragma unroll 8
    for (int i = 0; i < 32; ++i) { const int kk = 2 * i + (lane >> 5); float v = W[(size_t)(k0 + kk) * N + n0 + (lane & 31)]; if (gain) v *= gain[k0 + kk]; scr[kk * 33 + (lane & 31)] = v; }
    LDS_WAIT();
    const int c = lane & 7;
#pragma unroll
    for (int j = 0; j < 4; ++j) { const int n = (lane >> 3) + 8 * j; const LAS float* s = scr + (8 * c) * 33 + n;
        u32x4 o; o.x = cvt_pk_bf16(s[0 * 33], s[1 * 33]); o.y = cvt_pk_bf16(s[2 * 33], s[3 * 33]); o.z = cvt_pk_bf16(s[4 * 33], s[5 * 33]); o.w = cvt_pk_bf16(s[6 * 33], s[7 * 33]);
        const int nn = n0 + n; const int orow = (MAP == 1) ? ((((nn & 127) < 64) ? 0 : 512) + (nn >> 7) * 64 + (nn & 63)) : ((MAP == 2) ? (nn < 2464 ? nn : nn + 96) : nn);
        *(u32x4*)(WT + (size_t)orow * ldt + coff + k0 + 8 * c) = o; }
    LDS_WAIT();
}

__device__ __forceinline__ void grid_bar(unsigned* cnt, unsigned target) {
    asm volatile("s_waitcnt vmcnt(0)" ::: "memory");
    __syncthreads();
    if (threadIdx.x == 0) {
        __builtin_amdgcn_fence(__ATOMIC_RELEASE, "agent");
        asm volatile("s_waitcnt vmcnt(0)" ::: "memory");
        __hip_atomic_fetch_add(cnt, 1u, __ATOMIC_RELAXED, __HIP_MEMORY_SCOPE_AGENT);
        while (__hip_atomic_load(cnt, __ATOMIC_RELAXED, __HIP_MEMORY_SCOPE_AGENT) < target) __builtin_amdgcn_s_sleep(2);
        __builtin_amdgcn_fence(__ATOMIC_ACQUIRE, "agent");
        asm volatile("s_waitcnt vmcnt(0)" ::: "memory");
    }
    __syncthreads();
}

struct Args { const void* in[16]; float* out; unsigned char* ws; int lo, hi; };
constexpr int NPH = 8;
constexpr int LDS_BYTES = 135168;

__global__ void __launch_bounds__(512, 2) fwd(Args a) {
    extern __shared__ __attribute__((aligned(16))) unsigned char lds_raw[];
    LAS unsigned char* lds = (LAS unsigned char*)lds_raw;
    const int G = gridDim.x, bx = blockIdx.x;
    const int vcu = (G % 8 == 0) ? (bx % 8) * (G / 8) + bx / 8 : bx;
    const int NGW = G * 8, NGT = G * 512;
#define PH_IDS int tid = threadIdx.x; asm volatile("" : "+v"(tid)); const int lane = tid & 63, wave = __builtin_amdgcn_readfirstlane(tid >> 6); const int gw = vcu * 8 + wave, gt = bx * 512 + tid; (void)lane; (void)gw; (void)gt;
    unsigned char* ws = a.ws;
    const float* x = (const float*)a.in[0]; const int* pos = (const int*)a.in[1];
    const float* ln_in_g = (const float*)a.in[2]; const float* ln_in_b = (const float*)a.in[3];
    const float* w_in = (const float*)a.in[4]; const float* b_in = (const float*)a.in[5];
    const float* q_norm_g = (const float*)a.in[6]; const float* kv_norm_g = (const float*)a.in[7];
    const float* w_uq = (const float*)a.in[8]; const float* w_ukv = (const float*)a.in[9];
    const float* rel_bias = (const float*)a.in[10];
    const float* w_proj_a = (const float*)a.in[11]; const float* w_proj_b = (const float*)a.in[12]; const float* w_out = (const float*)a.in[13];
    const float* ln_post_g = (const float*)a.in[14]; const float* ln_post_b = (const float*)a.in[15];
    float* BIAS = (float*)(ws + WS_BIAS); float* STAT = (float*)(ws + WS_STAT); float* RS = (float*)(ws + WS_RS); float* CS = (float*)(ws + WS_CS);
    bf16_t* WUQ = (bf16_t*)(ws + WS_WUQ); bf16_t* WUKV = (bf16_t*)(ws + WS_WUKV); bf16_t* WP = (bf16_t*)(ws + WS_WP); bf16_t* WOUT = (bf16_t*)(ws + WS_WOUT); bf16_t* WIN = (bf16_t*)(ws + WS_WIN);
    bf16_t* KPE = (bf16_t*)(ws + WS_KPE); bf16_t* HB = (bf16_t*)(ws + WS_HB); bf16_t* QB = (bf16_t*)(ws + WS_QB); bf16_t* KB = (bf16_t*)(ws + WS_KB); bf16_t* VB = (bf16_t*)(ws + WS_VB);
    bf16_t* MIX = (bf16_t*)(ws + WS_MIX); bf16_t* PROJ = (bf16_t*)(ws + WS_PROJ); bf16_t* YAB = (bf16_t*)a.out;
    cg::grid_group grid = cg::this_grid();
    const int lo = a.lo, hi = a.hi;
#ifndef PHMASK
#define PHMASK 0xff
#endif
#define IN(k) (((PHMASK >> (k)) & 1) && lo <= (k) && (k) < hi)
    unsigned* barw = (unsigned*)ws;
#define SEAM(k) do { if (IN(k) && IN((k) + 1)) { if ((k) == 0) grid.sync(); else grid_bar(barw, (unsigned)(k) * (unsigned)G); } } while (0)

    if (IN(0)) {
        PH_IDS
        LAS float* scr = (LAS float*)(lds + wave * 16384);
        constexpr int I_IN = 16 * 157, I_UQ = 4 * 24, I_UKV = 2 * 32, I_PA = 8 * 32, I_PB = 8 * 32, I_OUT = 16 * 32;
        constexpr int NITEMS = I_IN + I_UQ + I_UKV + I_PA + I_PB + I_OUT;
        for (int it = gw; it < NITEMS; it += NGW) {
            int r = it;
            if (r < I_IN) { tr_item<2>(w_in, INC, WIN, 1024, 0, nullptr, scr, r, lane); continue; } r -= I_IN;
            if (r < I_UQ) { tr_item<0>(w_uq, 768, WUQ, 256, 0, q_norm_g, scr, r, lane); continue; } r -= I_UQ;
            if (r < I_UKV) { tr_item<1>(w_ukv, 1024, WUKV, 256, 0, kv_norm_g, scr, r, lane); continue; } r -= I_UKV;
            if (r < I_PA) { tr_item<0>(w_proj_a, 1024, WP, 1024, 0, nullptr, scr, r, lane); continue; } r -= I_PA;
            if (r < I_PB) { tr_item<0>(w_proj_b, 1024, WP, 1024, 512, nullptr, scr, r, lane); continue; } r -= I_PB;
            tr_item<0>(w_out, 1024, WOUT, 1024, 0, nullptr, scr, r, lane);
        }
        for (int i = gt; i < 12288; i += NGT) *(u32x4*)(WIN + (size_t)2464 * 1024 + (size_t)i * 8) = (u32x4){0u, 0u, 0u, 0u};
        for (int i = gt; i < 16384; i += NGT) *(u32x4*)(WUKV + (size_t)(i >> 4) * 256 + 128 + (i & 15) * 8) = (u32x4){0u, 0u, 0u, 0u};
        for (int i = gt; i < INCP; i += NGT) BIAS[i] = (i < 2464) ? b_in[i] : ((i < 2560) ? 0.f : b_in[i - 96]);
        for (int i = gt; i < NTOK * 16; i += NGT) { const int t = i >> 4, k = i & 15; const float inv = exp2f(-(float)k * 0.83048202372184058f); const float ang = (float)pos[t] * inv;
            CS[(size_t)t * 32 + k] = cosf(ang); CS[(size_t)t * 32 + 16 + k] = sinf(ang); }
        for (int m = gw; m < NTOK; m += NGW) {
            const f32x4* xr = (const f32x4*)(x + (size_t)m * DMOD) + lane; f32x4 v[4]; float s = 0.f;
#pragma unroll
            for (int j = 0; j < 4; ++j) { v[j] = xr[64 * j]; s += (v[j].x + v[j].y) + (v[j].z + v[j].w); }
            const float mean = wave_sum(s) * (1.f / DMOD); float s2 = 0.f;
#pragma unroll
            for (int j = 0; j < 4; ++j) { v[j] = v[j] - mean; s2 += (v[j].x * v[j].x + v[j].y * v[j].y) + (v[j].z * v[j].z + v[j].w * v[j].w); }
            const float rstd = 1.f / sqrtf(wave_sum(s2) * (1.f / DMOD) + LN_EPS);
            if (lane == 0) { STAT[2 * m] = mean; STAT[2 * m + 1] = rstd; }
            u32x2* o8 = (u32x2*)(HB + (size_t)m * DMOD) + lane;
#pragma unroll
            for (int j = 0; j < 4; ++j) { const f32x4 gv = ((const f32x4*)ln_in_g)[lane + 64 * j], bv = ((const f32x4*)ln_in_b)[lane + 64 * j]; const f32x4 hv = v[j] * rstd * gv + bv;
                u32x2 w; w.x = cvt_pk_bf16(hv.x, hv.y); w.y = cvt_pk_bf16(hv.z, hv.w); o8[64 * j] = w; }
        }
        __syncthreads();
    }
    SEAM(0);
    if (IN(1)) {
        pg8::Gemm g{HB, WIN, NTOK, INCP, 1024, 1024, 1024}; pg8::StaticOrder S; S.init(NTOK, INCP, G, bx);
        pg8::EpiProj E{PROJ, BIAS};
        pg8::gemm_phase<pg8::EpiProj>(lds, g, S, E);
    }
    SEAM(1);
    if (IN(2)) {
        PH_IDS
        for (int m = gw; m < NTOK; m += NGW) {
            const bf16_t* pr = PROJ + (size_t)m * INCP;
            const u32x2 cq = *((const u32x2*)(pr + C_CQ) + lane); const unsigned ck = *((const unsigned*)(pr + C_CKV) + lane);
            const float a0 = bf_lo(cq.x), a1 = bf_hi(cq.x), a2 = bf_lo(cq.y), a3 = bf_hi(cq.y), k0 = bf_lo(ck), k1 = bf_hi(ck);
            const float sq = wave_sum((a0 * a0 + a1 * a1) + (a2 * a2 + a3 * a3)), sk = wave_sum(k0 * k0 + k1 * k1);
            const float rq = 1.f / sqrtf(sq * (1.f / 256.f) + RMS_EPS), rk_ = 1.f / sqrtf(sk * (1.f / 128.f) + RMS_EPS);
            u32x2 cqn; cqn.x = cvt_pk_bf16(a0 * rq, a1 * rq); cqn.y = cvt_pk_bf16(a2 * rq, a3 * rq);
            *((u32x2*)(PROJ + (size_t)m * INCP + C_CQ) + lane) = cqn; *((unsigned*)(PROJ + (size_t)m * INCP + C_CKV) + lane) = cvt_pk_bf16(k0 * rk_, k1 * rk_);
            if (lane < 16) { const float x1 = bf1(pr[C_KR + lane]), x2 = bf1(pr[C_KR + 16 + lane]); const float c = CS[(size_t)m * 32 + lane], s = CS[(size_t)m * 32 + 16 + lane];
                KPE[(size_t)m * 32 + lane] = (bf16_t)(cvt_pk_bf16(x1 * c - x2 * s, 0.f) & 0xffffu); KPE[(size_t)m * 32 + 16 + lane] = (bf16_t)(cvt_pk_bf16(x2 * c + x1 * s, 0.f) & 0xffffu); }
        }
    }
    SEAM(2);
    if (IN(3)) {
        { pg8::Gemm g{PROJ + C_CQ, WUQ, NTOK, 768, 256, INCP, 256}; pg8::StaticOrder S; S.init(NTOK, 768, G, bx);
          pg8::EpiQ E{QB, RS, CS}; pg8::gemm_phase<pg8::EpiQ>(lds, g, S, E); }
        { pg8::Gemm g{PROJ + C_CKV, WUKV, NTOK, 1024, 256, INCP, 256}; pg8::StaticOrder S; S.init(NTOK, 1024, G, G - 1 - bx);
          pg8::EpiKV E{KB, VB, RS}; pg8::gemm_phase<pg8::EpiKV>(lds, g, S, E); }
    }
    SEAM(3);
    if (IN(4)) {
        att::Ptrs P{PROJ, QB, KB, VB, KPE, YAB, rel_bias};
        for (int j = vcu; j < 1024; j += G) { const int r = j >> 8, v = j & 255, bh = v >> 3, s = v & 7; const int qb = (r == 0) ? s : (r == 1) ? 15 - s : (r == 2) ? 16 + s : 31 - s;
            att::attn_unit<1>((LAS char*)lds, bh >> 3, bh & 7, qb, P); }
        for (int j = vcu; j < 1024; j += G) { const int bh = j >> 5, qb = j & 31; att::attn_unit<0>((LAS char*)lds, bh >> 3, bh & 7, qb, P); }
    }
    SEAM(4);
    if (IN(5)) {
        pg8::StaticOrder S; S.init(NTOK, 1024, G, bx);
        { pg8::Gemm g{YAB, WP, NTOK, 1024, 512, 1024, 1024}; pg8::EpiMix<0> E{MIX, PROJ}; pg8::gemm_phase<pg8::EpiMix<0>>(lds, g, S, E); }
        { pg8::Gemm g{YAB + 512, WP + 512, NTOK, 1024, 512, 1024, 1024}; pg8::EpiMix<1> E{MIX, PROJ}; pg8::gemm_phase<pg8::EpiMix<1>>(lds, g, S, E); }
    }
    SEAM(5);
    if (IN(6)) {
        pg8::Gemm g{MIX, WOUT, NTOK, 1024, 1024, 1024, 1024}; pg8::StaticOrder S; S.init(NTOK, 1024, G, bx);
        pg8::EpiOut E{a.out, x, STAT, ln_in_g, ln_in_b}; pg8::gemm_phase<pg8::EpiOut>(lds, g, S, E);
    }
    SEAM(6);
    if (IN(7)) {
        PH_IDS
        for (int m = gw; m < NTOK; m += NGW) {
            f32x4* xr = (f32x4*)(a.out + (size_t)m * DMOD) + lane; f32x4 v[4]; float s = 0.f;
#pragma unroll
            for (int j = 0; j < 4; ++j) { v[j] = xr[64 * j]; s += (v[j].x + v[j].y) + (v[j].z + v[j].w); }
            const float mean = wave_sum(s) * (1.f / DMOD); float s2 = 0.f;
#pragma unroll
            for (int j = 0; j < 4; ++j) { v[j] = v[j] - mean; s2 += (v[j].x * v[j].x + v[j].y * v[j].y) + (v[j].z * v[j].z + v[j].w * v[j].w); }
            const float rstd = 1.f / sqrtf(wave_sum(s2) * (1.f / DMOD) + LN_EPS);
#pragma unroll
            for (int j = 0; j < 4; ++j) { const f32x4 gv = ((const f32x4*)ln_post_g)[lane + 64 * j], bv = ((const f32x4*)ln_post_b)[lane + 64 * j]; xr[64 * j] = v[j] * rstd * gv + bv; }
        }
    }
#undef IN
#undef SEAM
}

extern "C" void kernel_launch(void* const* d_in, const int* in_sizes, int n_in, void* d_out, int out_size, void* d_ws, size_t ws_size, hipStream_t stream) {
    static int grid = 0;
    if (grid == 0) {
        if (n_in != 16 || out_size != NTOK * DMOD || ws_size < WS_END) { fprintf(stderr, "kernel_launch: unexpected shapes (n_in %d, out %d, ws %zu)\n", n_in, out_size, ws_size); grid = -1; return; }
        int dev = 0, cus = 0, per_cu = 0;
        hipGetDevice(&dev); hipDeviceGetAttribute(&cus, hipDeviceAttributeMultiprocessorCount, dev);
        hipFuncSetAttribute((const void*)fwd, hipFuncAttributeMaxDynamicSharedMemorySize, LDS_BYTES);
        hipOccupancyMaxActiveBlocksPerMultiprocessor(&per_cu, (const void*)fwd, 512, LDS_BYTES);
        (void)hipGetLastError();
        if (per_cu < 1) per_cu = 1;
        grid = cus;
        if (grid > cus * per_cu) grid = cus * per_cu;
    }
    if (grid < 0) return;
    hipMemsetAsync(d_ws, 0, 4096, stream);
    Args a{};
    for (int i = 0; i < 16; ++i) a.in[i] = d_in[i];
    a.out = (float*)d_out; a.ws = (unsigned char*)d_ws;
#if ONE_LAUNCH
    a.lo = 0; a.hi = NPH;
    void* args[] = {&a};
    hipError_t e = hipLaunchCooperativeKernel((const void*)fwd, dim3(grid), dim3(512), args, LDS_BYTES, stream);
    if (e != hipSuccess) fprintf(stderr, "cooperative launch failed: %s (grid %d)\n", hipGetErrorString(e), grid);
#else
    for (int p = 0; p < NPH; ++p) { a.lo = p; a.hi = p + 1; hipLaunchKernelGGL(fwd, dim3(grid), dim3(512), LDS_BYTES, stream, a); }
#endif
}
```

```cpp
#include <hip/hip_runtime.h>
#include <hip/hip_cooperative_groups.h>
#include <cstdio>
#include <cstdint>
namespace cg = cooperative_groups;

#ifndef ONE_LAUNCH
#define ONE_LAUNCH 1
#endif

#define LAS __attribute__((address_space(3)))
typedef unsigned short bf16_t;
typedef short bf16x8 __attribute__((ext_vector_type(8)));
typedef short s16x4 __attribute__((ext_vector_type(4)));
typedef float f32x2 __attribute__((ext_vector_type(2)));
typedef float f32x4 __attribute__((ext_vector_type(4)));
typedef float f32x16 __attribute__((ext_vector_type(16)));
typedef unsigned u32x2 __attribute__((ext_vector_type(2)));
typedef unsigned u32x4 __attribute__((ext_vector_type(4)));

constexpr int NTOK = 32768, DMOD = 1024, SEQ = 8192;
constexpr int INC = 5024, INCP = 5120;
constexpr int C_AQ = 0, C_AK = 512, C_AV = 1024, C_AZ = 1536, C_CQ = 2048, C_CKV = 2304, C_KR = 2432, C_BZ = 2560, C_GA = 3072, C_GB = 4096;
constexpr float LOG2E = 1.4426950408889634f;
constexpr float C2A = 0.125f * LOG2E;
constexpr float C2B = 0.10206207261596575f * LOG2E;
constexpr float ALPHA = 1.189207115002721f;
constexpr float LN_EPS = 1e-5f, RMS_EPS = 1e-6f;

constexpr size_t MiB = 1u << 20;
constexpr size_t WS_BIAS = 1 * MiB;
constexpr size_t WS_STAT = 2 * MiB;
constexpr size_t WS_RS = 2 * MiB + 512 * 1024;
constexpr size_t WS_WUQ = 3 * MiB;
constexpr size_t WS_WUKV = 3 * MiB + 512 * 1024;
constexpr size_t WS_WP = 4 * MiB;
constexpr size_t WS_WOUT = 6 * MiB;
constexpr size_t WS_CS = 8 * MiB;
constexpr size_t WS_WIN = 12 * MiB;
constexpr size_t WS_KPE = 22 * MiB;
constexpr size_t WS_HB = 24 * MiB;
constexpr size_t WS_QB = 24 * MiB;
constexpr size_t WS_KB = 88 * MiB;
constexpr size_t WS_VB = 120 * MiB;
constexpr size_t WS_MIX = 88 * MiB;
constexpr size_t WS_PROJ = 152 * MiB;
constexpr size_t WS_PART = 24 * MiB;
constexpr size_t WS_END = 472 * MiB;

__device__ __forceinline__ unsigned cvt_pk_bf16(float lo, float hi) { unsigned r; asm volatile("v_cvt_pk_bf16_f32 %0, %1, %2" : "=v"(r) : "v"(lo), "v"(hi)); return r; }
__device__ __forceinline__ float bf_lo(unsigned w) { return __uint_as_float(w << 16); }
__device__ __forceinline__ float bf_hi(unsigned w) { return __uint_as_float(w & 0xffff0000u); }
__device__ __forceinline__ float bf1(bf16_t b) { return __uint_as_float(((unsigned)b) << 16); }
__device__ __forceinline__ float wave_sum(float v) {
#pragma unroll
    for (int o = 1; o < 64; o <<= 1) v += __shfl_xor(v, o);
    return v;
}
__device__ __forceinline__ float sigmoidf_(float x) { return __builtin_amdgcn_rcpf(1.0f + __builtin_amdgcn_exp2f(-x * LOG2E)); }
#define LDS_WAIT() asm volatile("s_waitcnt lgkmcnt(0)" ::: "memory")

namespace pg8 {
constexpr int BM = 256, BK = 64, HALF = 128, HTB = HALF * BK * 2, STAGE_BYTES = 8 * HTB, NXCD = 8, WGM = 8;
__host__ __device__ __forceinline__ int lds_byte(int r, int c) { const int st = (r >> 4) * 2 + (c >> 5), rr = r & 15, cc = c & 31, ob = rr * 64 + cc * 2; return st * 1024 + (ob ^ (((ob >> 9) & 1) << 5)); }
__host__ __device__ __forceinline__ void stage_rc(int b, int& R, int& C) { const int st = b / 1024, sb = b % 1024, swz = sb ^ (((sb >> 9) & 1) << 5); R = (st >> 1) * 16 + swz / 64; C = (st & 1) * 32 + (swz % 64) / 2; }
__host__ __device__ __forceinline__ int perm32(int rho) { const int n = rho >> 4, i = rho & 15; return 8 * (i >> 2) + 4 * n + (i & 3); }

struct Unit { int pm, pn; };
struct Gemm { const bf16_t* A; const bf16_t* Bt; int M, N, K, lda, ldb; };

struct StaticOrder {
    int nM, nN, nwg, G, c;
    __device__ void init(int M, int N, int G_, int c_) { nM = M / BM; nN = N / BM; nwg = nM * nN; G = G_; c = c_; }
    __device__ bool next(int i, Unit& u) const {
        const long L = (long)i * G + c; if (L >= nwg) return false;
        int wgid = (int)L; { const int q = nwg / NXCD, r = nwg % NXCD, xcd = wgid % NXCD, off = wgid / NXCD; wgid = (xcd < r ? xcd * (q + 1) : r * (q + 1) + (xcd - r) * q) + off; }
        const int nig = WGM * nN, gid = wgid / nig, fm = gid * WGM, gsz = (nM - fm) < WGM ? (nM - fm) : WGM;
        u.pm = fm + ((wgid % nig) % gsz); u.pn = (wgid % nig) / gsz; return true;
    }
};

typedef f32x4 Acc[2][2][4][2];

struct EpiProj {
    static constexpr bool PERM = true; static constexpr int MID_T = -1;
    bf16_t* O; const float* bias;
    __device__ __forceinline__ void mid(Acc&, const Unit&, int, int, int, int) const {}
    __device__ __forceinline__ void operator()(const Acc& acc, const Unit& u, int wr, int wc, int fr, int fq) const {
        const int row0 = u.pm * BM + wr * 64 + fr; const int col0 = u.pn * BM + wc * 32 + 8 * fq;
        const float sc = (u.pn < 2) ? C2A : 1.0f;
        const int actm = (u.pn >= 12) ? 2 : ((u.pn == 6 || u.pn == 7 || u.pn == 10 || u.pn == 11) ? 1 : 0);
        f32x4 bv[2][2];
#pragma unroll
        for (int bj = 0; bj < 2; ++bj)
#pragma unroll
            for (int n = 0; n < 2; ++n) bv[bj][n] = *(const f32x4*)(bias + col0 + bj * HALF + 4 * n);
#pragma unroll
        for (int ai = 0; ai < 2; ++ai)
#pragma unroll
            for (int m = 0; m < 4; ++m) { bf16_t* rowp = O + (size_t)(row0 + ai * HALF + m * 16) * INCP + col0;
#pragma unroll
                for (int bj = 0; bj < 2; ++bj) { f32x4 v0 = (acc[ai][bj][m][0] + bv[bj][0]) * sc, v1 = (acc[ai][bj][m][1] + bv[bj][1]) * sc;
                    if (actm) {
#pragma unroll
                        for (int j = 0; j < 4; ++j) { const float s0 = sigmoidf_(v0[j]), s1 = sigmoidf_(v1[j]); v0[j] = (actm == 2) ? s0 : v0[j] * s0; v1[j] = (actm == 2) ? s1 : v1[j] * s1; } }
                    u32x4 w; w.x = cvt_pk_bf16(v0[0], v0[1]); w.y = cvt_pk_bf16(v0[2], v0[3]); w.z = cvt_pk_bf16(v1[0], v1[1]); w.w = cvt_pk_bf16(v1[2], v1[3]);
                    *(u32x4*)(rowp + bj * HALF) = w; } }
    }
};
struct EpiKV {
    static constexpr bool PERM = true; static constexpr int MID_T = -1;
    bf16_t* KBp; bf16_t* VBp; const float* rs;
    __device__ __forceinline__ void mid(Acc&, const Unit&, int, int, int, int) const {}
    __device__ __forceinline__ void operator()(const Acc& acc, const Unit& u, int wr, int wc, int fr, int fq) const {
        const int row0 = u.pm * BM + wr * 64 + fr; int colt = u.pn * BM; bf16_t* base = KBp; if (colt >= 512) { base = VBp; colt -= 512; }
        const int col0 = colt + wc * 32 + 8 * fq;
#pragma unroll
        for (int ai = 0; ai < 2; ++ai)
#pragma unroll
            for (int m = 0; m < 4; ++m) { const int row = row0 + ai * HALF + m * 16; bf16_t* rowp = base + (size_t)row * 512 + col0;
#pragma unroll
                for (int bj = 0; bj < 2; ++bj) { const f32x4 v0 = acc[ai][bj][m][0], v1 = acc[ai][bj][m][1];
                    u32x4 w; w.x = cvt_pk_bf16(v0[0], v0[1]); w.y = cvt_pk_bf16(v0[2], v0[3]); w.z = cvt_pk_bf16(v1[0], v1[1]); w.w = cvt_pk_bf16(v1[2], v1[3]);
                    *(u32x4*)(rowp + bj * HALF) = w; } }
    }
};
struct EpiQ {
    static constexpr bool PERM = false; static constexpr int MID_T = -1;
    bf16_t* QBp; const float* rs; const float* cs;
    __device__ __forceinline__ void mid(Acc&, const Unit&, int, int, int, int) const {}
    __device__ __forceinline__ void operator()(const Acc& acc, const Unit& u, int wr, int wc, int fr, int fq) const {
        const int row0 = u.pm * BM + wr * 64 + fr;
#pragma unroll
        for (int bj = 0; bj < 2; ++bj) { const int cb = u.pn * BM + bj * HALF + wc * 32; const bool rope = ((cb >> 5) % 3) == 2;
#pragma unroll
            for (int ai = 0; ai < 2; ++ai)
#pragma unroll
                for (int m = 0; m < 4; ++m) { const int row = row0 + ai * HALF + m * 16;
                    f32x4 x1 = acc[ai][bj][m][0] * C2B, x2 = acc[ai][bj][m][1] * C2B;
                    if (rope) { const f32x4 cv = *(const f32x4*)(cs + (size_t)row * 32 + 4 * fq), sv = *(const f32x4*)(cs + (size_t)row * 32 + 16 + 4 * fq);
                        const f32x4 o1 = x1 * cv - x2 * sv, o2 = x2 * cv + x1 * sv; x1 = o1; x2 = o2; }
                    u32x2 w1, w2; w1.x = cvt_pk_bf16(x1[0], x1[1]); w1.y = cvt_pk_bf16(x1[2], x1[3]); w2.x = cvt_pk_bf16(x2[0], x2[1]); w2.y = cvt_pk_bf16(x2[2], x2[3]);
                    bf16_t* p = QBp + (size_t)row * 768 + cb + 4 * fq;
                    *(u32x2*)p = w1; *(u32x2*)(p + 16) = w2;
                    asm volatile("" ::: "memory"); } }
    }
};
template <int SECOND> struct EpiMix {
    static constexpr bool PERM = true; static constexpr int MID_T = -1;
    bf16_t* MIXp; const bf16_t* PROJp;
    __device__ __forceinline__ void mid(Acc&, const Unit&, int, int, int, int) const {}
    __device__ __forceinline__ void operator()(const Acc& acc, const Unit& u, int wr, int wc, int fr, int fq) const {
        const int row0 = u.pm * BM + wr * 64 + fr; const int col0 = u.pn * BM + wc * 32 + 8 * fq;
#pragma unroll
        for (int ai = 0; ai < 2; ++ai)
#pragma unroll
            for (int m = 0; m < 4; ++m) { const size_t row = (size_t)(row0 + ai * HALF + m * 16); const bf16_t* rowp = PROJp + row * INCP + col0 + (SECOND ? C_GB : C_GA);
#pragma unroll
                for (int bj = 0; bj < 2; ++bj) { const u32x4 gt = *(const u32x4*)(rowp + bj * HALF); u32x4 pv = (u32x4){0u, 0u, 0u, 0u};
                    if (SECOND) pv = *(const u32x4*)(MIXp + row * DMOD + col0 + bj * HALF);
                    float o[8];
#pragma unroll
                    for (int j = 0; j < 4; ++j) { o[2 * j] = bf_lo(pv[j]) + acc[ai][bj][m][j >> 1][(j & 1) * 2] * bf_lo(gt[j]); o[2 * j + 1] = bf_hi(pv[j]) + acc[ai][bj][m][j >> 1][(j & 1) * 2 + 1] * bf_hi(gt[j]); }
                    u32x4 w; w.x = cvt_pk_bf16(o[0], o[1]); w.y = cvt_pk_bf16(o[2], o[3]); w.z = cvt_pk_bf16(o[4], o[5]); w.w = cvt_pk_bf16(o[6], o[7]);
                    *(u32x4*)(MIXp + row * DMOD + col0 + bj * HALF) = w; }
                asm volatile("" ::: "memory"); }
    }
};
struct EpiOut {
    static constexpr bool PERM = false; static constexpr int MID_T = -1;
    float* Y; const float* X; const float* stat; const float* g; const float* b; float* part;
    __device__ __forceinline__ void mid(Acc&, const Unit&, int, int, int, int) const {}
    __device__ __forceinline__ void operator()(const Acc& acc, const Unit& u, int wr, int wc, int fr, int fq) const {
        const int row0 = u.pm * BM + wr * 64 + fr; const int col0 = u.pn * BM + wc * 32 + 4 * fq;
        f32x4 gv[2][2], bv[2][2];
#pragma unroll
        for (int bj = 0; bj < 2; ++bj)
#pragma unroll
            for (int n = 0; n < 2; ++n) { gv[bj][n] = *(const f32x4*)(g + col0 + bj * HALF + n * 16) * ALPHA; bv[bj][n] = *(const f32x4*)(b + col0 + bj * HALF + n * 16) * ALPHA; }
#pragma unroll
        for (int ai = 0; ai < 2; ++ai)
#pragma unroll
            for (int m = 0; m < 4; ++m) { const size_t row = (size_t)(row0 + ai * HALF + m * 16); const f32x2 st = *(const f32x2*)(stat + 2 * row); const size_t off = row * DMOD + col0;
                float s1 = 0.f, s2 = 0.f;
#pragma unroll
                for (int bj = 0; bj < 2; ++bj)
#pragma unroll
                    for (int n = 0; n < 2; ++n) { const f32x4 xv = *(const f32x4*)(X + off + bj * HALF + n * 16);
                        const f32x4 o = ((xv - st.x) * st.y) * gv[bj][n] + bv[bj][n] + acc[ai][bj][m][n];
                        s1 += (o[0] + o[1]) + (o[2] + o[3]); s2 += (o[0] * o[0] + o[1] * o[1]) + (o[2] * o[2] + o[3] * o[3]);
                        *(f32x4*)(Y + off + bj * HALF + n * 16) = o; }
                s1 += __shfl_xor(s1, 16); s1 += __shfl_xor(s1, 32); s2 += __shfl_xor(s2, 16); s2 += __shfl_xor(s2, 32);
                if (fq == 0) *(f32x2*)(part + row * 32 + (u.pn * 4 + wc) * 2) = (f32x2){s1, s2};
                asm volatile("" ::: "memory"); }
    }
};

template <class Epi, bool ALIGN_EPI = true, bool SP2 = true>
__device__ __forceinline__ void gemm_phase(LAS unsigned char* lds, const Gemm g, const StaticOrder& S, const Epi& E) {
    const int tid = threadIdx.x, wid = __builtin_amdgcn_readfirstlane(tid >> 6), lane = tid & 63, wr = wid >> 2, wc = wid & 3, fr = lane & 15, fq = lane >> 4;
    const int K = g.K, nt = K / BK;
    unsigned voffA[2], voffB[2];
#pragma unroll
    for (int i = 0; i < 2; ++i) { int R, C; stage_rc(tid * 16 + i * 8192, R, C); const int Rb = Epi::PERM ? ((R & ~31) + perm32(R & 31)) : R;
        voffA[i] = (unsigned)(R * g.lda + C) * 2u; voffB[i] = (unsigned)(Rb * g.ldb + C) * 2u; }
    const size_t kstep = (size_t)(BK * 2);
    const size_t hsA = (size_t)HALF * g.lda * 2, hsB = (size_t)HALF * g.ldb * 2;
    const size_t tsA = 2 * hsA, tsB = 2 * hsB;
    const unsigned ldsw = (unsigned)wid * 1024u;
    const int aoff = lds_byte(wr * 64 + fr, fq * 8), boff = lds_byte(wc * 32 + fr, fq * 8);
#define PG8_SA(b, h) (((b) * 2 + (h)) * HTB)
#define PG8_SB(b, h) ((4 + (b) * 2 + (h)) * HTB)
#define PG8_STAGE(bufoff, gbase, voff) do { _Pragma("unroll") for (int _i = 0; _i < 2; ++_i) \
        __builtin_amdgcn_global_load_lds((const unsigned*)((const char*)(gbase) + (voff)[_i]), (LAS unsigned*)(lds + (bufoff) + ldsw + _i * 8192), 16, 0, 0); } while (0)
#define PG8_LDA(dst, b, h) do { _Pragma("unroll") for (int m = 0; m < 4; ++m) _Pragma("unroll") for (int k = 0; k < 2; ++k) dst[m][k] = *(const LAS bf16x8*)(lds + PG8_SA(b, h) + aoff + m * 2048 + k * 1024); } while (0)
#define PG8_LDB(dst, b, h) do { _Pragma("unroll") for (int n = 0; n < 2; ++n) _Pragma("unroll") for (int k = 0; k < 2; ++k) dst[n][k] = *(const LAS bf16x8*)(lds + PG8_SB(b, h) + boff + n * 2048 + k * 1024); } while (0)
#define PG8_MMA(ai, bj, At, Bt) do { __builtin_amdgcn_s_setprio(1); _Pragma("unroll") for (int m = 0; m < 4; ++m) _Pragma("unroll") for (int n = 0; n < 2; ++n) _Pragma("unroll") for (int k = 0; k < 2; ++k) \
        acc[ai][bj][m][n] = __builtin_amdgcn_mfma_f32_16x16x32_bf16(Bt[n][k], At[m][k], acc[ai][bj][m][n], 0, 0, 0); __builtin_amdgcn_s_setprio(0); } while (0)
#define PG8_WAIT_V(n) asm volatile("s_waitcnt vmcnt(" #n ")" ::: "memory")
#define PG8_WAIT_L(n) asm volatile("s_waitcnt lgkmcnt(" #n ")" ::: "memory")
#define PG8_BAR __builtin_amdgcn_s_barrier()
#define PG8_SCHED __builtin_amdgcn_sched_barrier(0)
    Unit cur, nxt; int ui = 0;
    if (!S.next(0, cur)) return;
    Acc acc;
#pragma unroll
    for (int a = 0; a < 2; ++a)
#pragma unroll
        for (int b = 0; b < 2; ++b)
#pragma unroll
            for (int m = 0; m < 4; ++m)
#pragma unroll
                for (int n = 0; n < 2; ++n) acc[a][b][m][n] = (f32x4){0.f, 0.f, 0.f, 0.f};
    bf16x8 At[4][2], B0[2][2], B1[2][2];
    const char* cA = (const char*)g.A + (size_t)cur.pm * tsA; const char* cB = (const char*)g.Bt + (size_t)cur.pn * tsB;
    if constexpr (SP2) {
        PG8_STAGE(PG8_SB(0, 0), cB, voffB); PG8_STAGE(PG8_SB(0, 1), cB + hsB, voffB); PG8_STAGE(PG8_SA(0, 0), cA, voffA); PG8_STAGE(PG8_SA(0, 1), cA + hsA, voffA);
        if (wr == 1) PG8_BAR;
        PG8_WAIT_V(2); PG8_BAR;
        PG8_STAGE(PG8_SB(1, 0), cB + kstep, voffB); PG8_STAGE(PG8_SA(1, 0), cA + kstep, voffA); PG8_STAGE(PG8_SB(1, 1), cB + hsB + kstep, voffB);
        PG8_WAIT_V(6); PG8_BAR;
    }
    for (;;) {
        const bool has_next = S.next(ui + 1, nxt);
        const char* nA = has_next ? (const char*)g.A + (size_t)nxt.pm * tsA : cA; const char* nB = has_next ? (const char*)g.Bt + (size_t)nxt.pn * tsB : cB;
#pragma unroll 1
        for (int t = 0; t < nt; t += 2) {
            const bool last = (t == nt - 2);
            const char* a1 = cA + (size_t)(t + 1) * kstep;
            const char* a2 = last ? nA : cA + (size_t)(t + 2) * kstep; const char* b2 = last ? nB : cB + (size_t)(t + 2) * kstep;
            const char* a3 = a2 + kstep; const char* b3 = b2 + kstep;
            if constexpr (Epi::MID_T >= 0) { if (t == Epi::MID_T) E.mid(acc, cur, wr, wc, fr, fq); }
            PG8_LDB(B0, 0, 0); PG8_LDB(B1, 0, 1); PG8_SCHED; PG8_LDA(At, 0, 0); PG8_STAGE(PG8_SA(1, 1), a1 + hsA, voffA);
            PG8_WAIT_V(8); PG8_WAIT_L(0); PG8_BAR; PG8_MMA(0, 0, At, B0); PG8_MMA(0, 1, At, B1); PG8_BAR; PG8_SCHED;
            PG8_LDA(At, 0, 1); PG8_STAGE(PG8_SB(0, 0), b2, voffB); PG8_STAGE(PG8_SB(0, 1), b2 + hsB, voffB); PG8_STAGE(PG8_SA(0, 0), a2, voffA);
            PG8_WAIT_V(8); PG8_WAIT_L(0); PG8_BAR; PG8_MMA(1, 0, At, B0); PG8_MMA(1, 1, At, B1); PG8_BAR; PG8_SCHED;
            PG8_LDB(B0, 1, 0); PG8_LDB(B1, 1, 1); PG8_SCHED; PG8_LDA(At, 1, 0); PG8_STAGE(PG8_SA(0, 1), a2 + hsA, voffA);
            PG8_WAIT_V(8); PG8_WAIT_L(0); PG8_BAR; PG8_MMA(0, 0, At, B0); PG8_MMA(0, 1, At, B1); PG8_BAR; PG8_SCHED;
            PG8_LDA(At, 1, 1); PG8_STAGE(PG8_SB(1, 0), b3, voffB); PG8_STAGE(PG8_SB(1, 1), b3 + hsB, voffB); PG8_STAGE(PG8_SA(1, 0), a3, voffA);
            PG8_WAIT_V(8); PG8_WAIT_L(0); PG8_BAR; PG8_MMA(1, 0, At, B0); PG8_MMA(1, 1, At, B1); PG8_BAR; PG8_SCHED;
        }
        if constexpr (ALIGN_EPI) { if (wr == 0) PG8_BAR; }
        E(acc, cur, wr, wc, fr, fq);
        if (!has_next) break;
#pragma unroll
        for (int a = 0; a < 2; ++a)
#pragma unroll
            for (int b = 0; b < 2; ++b)
#pragma unroll
                for (int m = 0; m < 4; ++m)
#pragma unroll
                    for (int n = 0; n < 2; ++n) acc[a][b][m][n] = (f32x4){0.f, 0.f, 0.f, 0.f};
        cur = nxt; cA = nA; cB = nB; ++ui;
        if constexpr (ALIGN_EPI) { if (wr == 1) PG8_BAR; }
    }
    PG8_WAIT_V(0);
    if constexpr (!ALIGN_EPI) { if (wr == 0) PG8_BAR; }
    PG8_BAR;
#undef PG8_SA
#undef PG8_SB
#undef PG8_STAGE
#undef PG8_LDA
#undef PG8_LDB
#undef PG8_MMA
#undef PG8_WAIT_V
#undef PG8_WAIT_L
#undef PG8_BAR
#undef PG8_SCHED
}
}

namespace att {
constexpr int KOFF = 0, KSLOT = 12288, VOFF = 24576, VSLOT = 8192, WSF = 40960, OST = 43008, TAB = 75776, LDS_END = 77824;
constexpr float THR = 8.0f;
__device__ __forceinline__ int crow(int r, int hi) { return (r & 3) + 8 * (r >> 2) + 4 * hi; }
typedef short v4i16_t __attribute__((ext_vector_type(4)));
__device__ __forceinline__ s16x4 vtr(const LAS char* p) { return __builtin_bit_cast(s16x4, __builtin_amdgcn_ds_read_tr16_b64_v4i16((LAS v4i16_t*)p)); }

struct Ptrs { const bf16_t* PROJ; const bf16_t* QB; const bf16_t* KB; const bf16_t* VB; const bf16_t* KPE; bf16_t* YAB; const float* relb; };

__device__ __forceinline__ float max3_(float a, float b, float c) { return fmaxf(fmaxf(a, b), c); }
__device__ __forceinline__ float xhalf_max(float v) { auto rr = __builtin_amdgcn_permlane32_swap(__float_as_uint(v), __float_as_uint(v), false, false); return fmaxf(__uint_as_float(rr[0]), __uint_as_float(rr[1])); }
__device__ __forceinline__ float xhalf_sum(float v) { auto rr = __builtin_amdgcn_permlane32_swap(__float_as_uint(v), __float_as_uint(v), false, false); return __uint_as_float(rr[0]) + __uint_as_float(rr[1]); }

template <int MODE, bool DO_Q, bool DO_S>
__device__ __forceinline__ void att_step(const LAS char* kb, const LAS char* vp, const bf16x8 (&qr)[MODE ? 6 : 4], f32x16& pc0, f32x16& pc1, f32x16& pn0, f32x16& pn1, f32x16& o0, f32x16& o1,
                                         float& l_run, float nm, int dt, int ql, int hi, const LAS float* tab) {
    constexpr int ND0 = MODE ? 6 : 4;
    if (DO_Q) {
        if (MODE == 0) {
            if (dt >= 3) { const float bc = nm + tab[256];
#pragma unroll
                for (int r = 0; r < 16; ++r) { pn0[r] = bc; pn1[r] = bc; } }
            else {
#pragma unroll
                for (int r = 0; r < 16; ++r) { const int d0_ = 64 * dt + ql - crow(r, hi); const int i0 = (d0_ < 128 ? d0_ : 128) + 128; const int d1_ = d0_ - 32; const int i1 = (d1_ < 128 ? d1_ : 128) + 128;
                    pn0[r] = nm + tab[i0]; pn1[r] = nm + tab[i1]; } }
        } else {
#pragma unroll
            for (int r = 0; r < 16; ++r) { pn0[r] = nm; pn1[r] = nm; } }
#pragma unroll
        for (int d0 = 0; d0 < ND0; ++d0) {
            const bf16x8 a0 = *(const LAS bf16x8*)(kb + d0 * 2048), a1 = *(const LAS bf16x8*)(kb + d0 * 2048 + 512);
            pn0 = __builtin_amdgcn_mfma_f32_32x32x16_bf16(a0, qr[d0], pn0, 0, 0, 0);
            pn1 = __builtin_amdgcn_mfma_f32_32x32x16_bf16(a1, qr[d0], pn1, 0, 0, 0);
        }
    }
    if (DO_S) {
        float s0 = 0.f;
#pragma unroll
        for (int r = 0; r < 16; ++r) { pc0[r] = __builtin_amdgcn_exp2f(pc0[r]); pc1[r] = __builtin_amdgcn_exp2f(pc1[r]); s0 += pc0[r]; s0 += pc1[r]; }
        l_run += s0;
        u32x4 pw[4];
#pragma unroll
        for (int j = 0; j < 4; ++j) { pw[0][j] = cvt_pk_bf16(pc0[2 * j], pc0[2 * j + 1]); pw[1][j] = cvt_pk_bf16(pc0[8 + 2 * j], pc0[9 + 2 * j]);
            pw[2][j] = cvt_pk_bf16(pc1[2 * j], pc1[2 * j + 1]); pw[3][j] = cvt_pk_bf16(pc1[8 + 2 * j], pc1[9 + 2 * j]); }
#pragma unroll
        for (int ks = 0; ks < 4; ++ks) {
            const s16x4 l0 = vtr(vp + ks * 1024), h0 = vtr(vp + ks * 1024 + 512), l1 = vtr(vp + 4096 + ks * 1024), h1 = vtr(vp + 4096 + ks * 1024 + 512);
            const bf16x8 b0 = (bf16x8){l0[0], l0[1], l0[2], l0[3], h0[0], h0[1], h0[2], h0[3]}, b1 = (bf16x8){l1[0], l1[1], l1[2], l1[3], h1[0], h1[1], h1[2], h1[3]};
            const bf16x8 pa = __builtin_bit_cast(bf16x8, pw[ks]);
            o0 = __builtin_amdgcn_mfma_f32_32x32x16_bf16(pa, b0, o0, 0, 0, 0);
            o1 = __builtin_amdgcn_mfma_f32_32x32x16_bf16(pa, b1, o1, 0, 0, 0);
        }
    }
}

template <int MODE>
__device__ __forceinline__ void attn_unit(LAS char* lds, int b, int h, int qb, const Ptrs& P) {
    constexpr int ND0 = MODE ? 6 : 4;
    const int tid = threadIdx.x, lane = tid & 63, r32 = lane & 31, hi = lane >> 5; const int wid = __builtin_amdgcn_readfirstlane(tid >> 6);
    const size_t rowbase = (size_t)b * SEQ; const int q0 = qb * 256;
    const size_t qrow = rowbase + q0 + wid * 32 + r32;
    const bf16_t* Qp = MODE ? (P.QB + qrow * 768 + h * 96) : (P.PROJ + qrow * INCP + C_AQ + h * 64);
    bf16x8 qr[ND0];
#pragma unroll
    for (int d0 = 0; d0 < ND0; ++d0) qr[d0] = *(const bf16x8*)(Qp + d0 * 16 + hi * 8);
    const int cw = 4 * qb + (wid >> 1);
    const int t_first = MODE ? 0 : ((4 * qb - 8) > 0 ? (4 * qb - 8) : 0), t_last = 4 * qb + 3;
    const int w_lo = MODE ? 0 : (cw - 8);
    const int skey = tid >> 3, sc = tid & 7;
    const size_t ldk = MODE ? 512 : INCP;
    const bf16_t* ksrc = MODE ? (P.KB + (rowbase + skey) * 512 + h * 64 + sc * 8) : (P.PROJ + (rowbase + skey) * INCP + C_AK + h * 64 + sc * 8);
    const bf16_t* vsrc = MODE ? (P.VB + (rowbase + skey) * 512 + h * 64 + sc * 8) : (P.PROJ + (rowbase + skey) * INCP + C_AV + h * 64 + sc * 8);
    const bf16_t* psrc = P.KPE + (rowbase + (tid >> 2)) * 32 + (tid & 3) * 8;
    const int kdst = sc * 1024 + skey * 16, vdst = (sc >> 2) * 4096 + skey * 64 + (sc & 3) * 16, pdst = (8 + (tid & 3)) * 1024 + (tid >> 2) * 16;
    LAS float* wsf = (LAS float*)(lds + WSF + wid * 256);
    LAS float* tab = (LAS float*)(lds + TAB);
    if (MODE == 0) { if (tid < 257) tab[tid] = P.relb[tid * 8 + h] * LOG2E; }
    u32x4 rk, rv, rp;
#define ATT_LOADK(t) do { rk = *(const u32x4*)(ksrc + (size_t)(t) * 64 * ldk); if (MODE == 1) { if (tid < 256) rp = *(const u32x4*)(psrc + (size_t)(t) * 64 * 32); } } while (0)
#define ATT_LOADV(t) do { rv = *(const u32x4*)(vsrc + (size_t)(t) * 64 * ldk); } while (0)
#define ATT_STOREK(buf) do { *(LAS u32x4*)(lds + KOFF + (buf) * KSLOT + kdst) = rk; if (MODE == 1) { if (tid < 256) *(LAS u32x4*)(lds + KOFF + (buf) * KSLOT + pdst) = rp; } } while (0)
#define ATT_STOREV(buf) do { *(LAS u32x4*)(lds + VOFF + (buf) * VSLOT + vdst) = rv; } while (0)
    ATT_LOADK(t_first); ATT_STOREK(t_first & 1);
    __syncthreads();
    float m_run = 0.f, l_run = 0.f; bool first = true;
    f32x16 o0, o1, pc0, pc1, pn0, pn1;
#pragma unroll
    for (int r = 0; r < 16; ++r) { o0[r] = 0.f; o1[r] = 0.f; pc0[r] = 0.f; pc1[r] = 0.f; pn0[r] = 0.f; pn1[r] = 0.f; }
    const int ql = (wid & 1) * 32 + r32;
    const LAS char* kb0 = lds + KOFF + hi * 1024 + r32 * 16;
    const LAS char* vp0 = lds + VOFF + ((lane >> 4) & 1) * 32 + (lane & 3) * 8 + (4 * hi + ((lane & 15) >> 2)) * 64;
#pragma unroll 2
    for (int t = t_first - 1; t <= t_last; ++t) {
        const bool ldk2 = (t + 2 <= t_last), ldv1 = (t + 1 <= t_last);
        if (ldk2) ATT_LOADK(t + 2);
        if (ldv1) ATT_LOADV(t + 1);
        const bool actS = (t >= t_first) && (t >= w_lo) && (t <= cw);
        const bool actQ = (t + 1 >= w_lo) && (t + 1 <= cw);
        if (actS) {
            float rm = max3_(pc0[0], pc1[0], pc0[1]);
#pragma unroll
            for (int r = 1; r < 15; r += 2) rm = max3_(rm, pc1[r], pc0[r + 1]);
#pragma unroll
            for (int r = 2; r < 16; r += 2) rm = max3_(rm, pc1[r], pc0[r + 1 < 16 ? r + 1 : r]);
            rm = fmaxf(rm, pc1[15]);
            rm = xhalf_max(rm);
            if (first || __any(rm > THR)) {
                const float dl = first ? rm : fmaxf(rm, 0.f); m_run += dl;
#pragma unroll
                for (int r = 0; r < 16; ++r) { pc0[r] -= dl; pc1[r] -= dl; }
                if (!first) {
                    const float f = __builtin_amdgcn_exp2f(-dl); l_run *= f;
                    if (hi == 0) wsf[r32] = f;
                    LDS_WAIT();
#pragma unroll
                    for (int r = 0; r < 16; ++r) { const float fr_ = wsf[crow(r, hi)]; o0[r] *= fr_; o1[r] *= fr_; }
                }
                first = false;
            }
        }
        const LAS char* kb = kb0 + ((t + 1) & 1) * KSLOT; const LAS char* vp = vp0 + (t & 1) * VSLOT;
        const float nm = -m_run; const int dt = cw - (t + 1);
        if (actS && actQ) att_step<MODE, true, true>(kb, vp, qr, pc0, pc1, pn0, pn1, o0, o1, l_run, nm, dt, ql, hi, tab);
        else if (actS) att_step<MODE, false, true>(kb, vp, qr, pc0, pc1, pn0, pn1, o0, o1, l_run, nm, dt, ql, hi, tab);
        else if (actQ) att_step<MODE, true, false>(kb, vp, qr, pc0, pc1, pn0, pn1, o0, o1, l_run, nm, dt, ql, hi, tab);
        pc0 = pn0; pc1 = pn1;
        if (ldk2) ATT_STOREK(t & 1);
        if (ldv1) ATT_STOREV((t + 1) & 1);
        __syncthreads();
    }
#undef ATT_LOADK
#undef ATT_LOADV
#undef ATT_STOREK
#undef ATT_STOREV
    const float lt = xhalf_sum(l_run);
    if (hi == 0) wsf[32 + r32] = lt;
    LDS_WAIT();
    LAS bf16_t* stg = (LAS bf16_t*)(lds + OST + wid * 4096);
#pragma unroll
    for (int r = 0; r < 16; ++r) { const int orow = crow(r, hi); const float rl = __builtin_amdgcn_rcpf(wsf[32 + orow]);
        stg[orow * 64 + r32] = (bf16_t)(cvt_pk_bf16(o0[r] * rl, 0.f) & 0xffffu); stg[orow * 64 + 32 + r32] = (bf16_t)(cvt_pk_bf16(o1[r] * rl, 0.f) & 0xffffu); }
    LDS_WAIT();
    const int zc = MODE ? C_BZ : C_AZ;
#pragma unroll
    for (int i = 0; i < 4; ++i) { const int row = i * 8 + (lane >> 3), ch = lane & 7; const u32x4 v = *(const LAS u32x4*)(stg + row * 64 + ch * 8);
        const size_t grow = rowbase + q0 + wid * 32 + row;
        const u32x4 z = *(const u32x4*)(P.PROJ + grow * INCP + zc + h * 64 + ch * 8); u32x4 w;
#pragma unroll
        for (int j = 0; j < 4; ++j) w[j] = cvt_pk_bf16(bf_lo(v[j]) * bf_lo(z[j]), bf_hi(v[j]) * bf_hi(z[j]));
        *(u32x4*)(P.YAB + grow * DMOD + (MODE ? 512 : 0) + h * 64 + ch * 8) = w; }
    __syncthreads();
}
}

template <int MAP>
__device__ __forceinline__ void tr_item(const float* W, int N, bf16_t* WT, int ldt, int coff, const float* gain, LAS float* scr, int item, int lane) {
    const int nblk = N / 32, kb = item / nblk, nb = item % nblk, k0 = 64 * kb, n0 = 32 * nb;
#pragma unroll 8
    for (int i = 0; i < 32; ++i) { const int kk = 2 * i + (lane >> 5); float v = W[(size_t)(k0 + kk) * N + n0 + (lane & 31)]; if (gain) v *= gain[k0 + kk]; scr[kk * 33 + (lane & 31)] = v; }
    LDS_WAIT();
    const int c = lane & 7;
#pragma unroll
    for (int j = 0; j < 4; ++j) { const int n = (lane >> 3) + 8 * j; const LAS float* s = scr + (8 * c) * 33 + n;
        u32x4 o; o.x = cvt_pk_bf16(s[0 * 33], s[1 * 33]); o.y = cvt_pk_bf16(s[2 * 33], s[3 * 33]); o.z = cvt_pk_bf16(s[4 * 33], s[5 * 33]); o.w = cvt_pk_bf16(s[6 * 33], s[7 * 33]);
        const int nn = n0 + n; const int orow = (MAP == 1) ? ((((nn & 127) < 64) ? 0 : 512) + (nn >> 7) * 64 + (nn & 63)) : ((MAP == 2) ? (nn < 2464 ? nn : nn + 96) : nn);
        *(u32x4*)(WT + (size_t)orow * ldt + coff + k0 + 8 * c) = o; }
    LDS_WAIT();
}

__device__ __forceinline__ void grid_bar(unsigned* cnt, unsigned target) {
    asm volatile("s_waitcnt vmcnt(0)" ::: "memory");
    __syncthreads();
    if (threadIdx.x == 0) {
        __builtin_amdgcn_fence(__ATOMIC_RELEASE, "agent");
        asm volatile("s_waitcnt vmcnt(0)" ::: "memory");
        __hip_atomic_fetch_add(cnt, 1u, __ATOMIC_RELAXED, __HIP_MEMORY_SCOPE_AGENT);
        while (__hip_atomic_load(cnt, __ATOMIC_RELAXED, __HIP_MEMORY_SCOPE_AGENT) < target) __builtin_amdgcn_s_sleep(2);
        __builtin_amdgcn_fence(__ATOMIC_ACQUIRE, "agent");
        asm volatile("s_waitcnt vmcnt(0)" ::: "memory");
    }
    __syncthreads();
}

struct Args { const void* in[16]; float* out; unsigned char* ws; int lo, hi, sel, pad; };
constexpr int NPH = 8;
constexpr int LDS_BYTES = 135168;

__global__ void __launch_bounds__(512, 2) fwd(Args a) {
    extern __shared__ __attribute__((aligned(16))) unsigned char lds_raw[];
    LAS unsigned char* lds = (LAS unsigned char*)lds_raw;
    const int G = gridDim.x, bx = blockIdx.x;
    const int vcu = (G % 8 == 0) ? (bx % 8) * (G / 8) + bx / 8 : bx;
    const int NGW = G * 8, NGT = G * 512;
#define PH_IDS int tid = threadIdx.x; asm volatile("" : "+v"(tid)); const int lane = tid & 63, wave = __builtin_amdgcn_readfirstlane(tid >> 6); const int gw = vcu * 8 + wave, gt = bx * 512 + tid; (void)lane; (void)gw; (void)gt;
    unsigned char* ws = a.ws;
    const float* x = (const float*)a.in[0]; const int* pos = (const int*)a.in[1];
    const float* ln_in_g = (const float*)a.in[2]; const float* ln_in_b = (const float*)a.in[3];
    const float* w_in = (const float*)a.in[4]; const float* b_in = (const float*)a.in[5];
    const float* q_norm_g = (const float*)a.in[6]; const float* kv_norm_g = (const float*)a.in[7];
    const float* w_uq = (const float*)a.in[8]; const float* w_ukv = (const float*)a.in[9];
    const float* rel_bias = (const float*)a.in[10];
    const float* w_proj_a = (const float*)a.in[11]; const float* w_proj_b = (const float*)a.in[12]; const float* w_out = (const float*)a.in[13];
    const float* ln_post_g = (const float*)a.in[14]; const float* ln_post_b = (const float*)a.in[15];
    float* BIAS = (float*)(ws + WS_BIAS); float* STAT = (float*)(ws + WS_STAT); float* RS = (float*)(ws + WS_RS); float* CS = (float*)(ws + WS_CS); float* PART = (float*)(ws + WS_PART);
    bf16_t* WUQ = (bf16_t*)(ws + WS_WUQ); bf16_t* WUKV = (bf16_t*)(ws + WS_WUKV); bf16_t* WP = (bf16_t*)(ws + WS_WP); bf16_t* WOUT = (bf16_t*)(ws + WS_WOUT); bf16_t* WIN = (bf16_t*)(ws + WS_WIN);
    bf16_t* KPE = (bf16_t*)(ws + WS_KPE); bf16_t* HB = (bf16_t*)(ws + WS_HB); bf16_t* QB = (bf16_t*)(ws + WS_QB); bf16_t* KB = (bf16_t*)(ws + WS_KB); bf16_t* VB = (bf16_t*)(ws + WS_VB);
    bf16_t* MIX = (bf16_t*)(ws + WS_MIX); bf16_t* PROJ = (bf16_t*)(ws + WS_PROJ); bf16_t* YAB = (bf16_t*)a.out;
    cg::grid_group grid = cg::this_grid();
    const int lo = a.lo, hi = a.hi;
#ifndef PHMASK
#define PHMASK 0xff
#endif
#define IN(k) (((PHMASK >> (k)) & 1) && lo <= (k) && (k) < hi)
    unsigned* barw = (unsigned*)ws;
#define SEAM(k) do { if (IN(k) && IN((k) + 1)) { if ((k) == 0) grid.sync(); else grid_bar(barw, (unsigned)(k) * (unsigned)G); } } while (0)

    if (IN(0)) {
        PH_IDS
        LAS float* scr = (LAS float*)(lds + wave * 16384);
        constexpr int I_IN = 16 * 157, I_UQ = 4 * 24, I_UKV = 2 * 32, I_PA = 8 * 32, I_PB = 8 * 32, I_OUT = 16 * 32;
        constexpr int NITEMS = I_IN + I_UQ + I_UKV + I_PA + I_PB + I_OUT;
        for (int it = gw; it < NITEMS; it += NGW) {
            int r = it;
            if (r < I_IN) { tr_item<2>(w_in, INC, WIN, 1024, 0, nullptr, scr, r, lane); continue; } r -= I_IN;
            if (r < I_UQ) { tr_item<0>(w_uq, 768, WUQ, 256, 0, q_norm_g, scr, r, lane); continue; } r -= I_UQ;
            if (r < I_UKV) { tr_item<1>(w_ukv, 1024, WUKV, 256, 0, kv_norm_g, scr, r, lane); continue; } r -= I_UKV;
            if (r < I_PA) { tr_item<0>(w_proj_a, 1024, WP, 1024, 0, nullptr, scr, r, lane); continue; } r -= I_PA;
            if (r < I_PB) { tr_item<0>(w_proj_b, 1024, WP, 1024, 512, nullptr, scr, r, lane); continue; } r -= I_PB;
            tr_item<0>(w_out, 1024, WOUT, 1024, 0, nullptr, scr, r, lane);
        }
        for (int i = gt; i < 12288; i += NGT) *(u32x4*)(WIN + (size_t)2464 * 1024 + (size_t)i * 8) = (u32x4){0u, 0u, 0u, 0u};
        for (int i = gt; i < 16384; i += NGT) *(u32x4*)(WUKV + (size_t)(i >> 4) * 256 + 128 + (i & 15) * 8) = (u32x4){0u, 0u, 0u, 0u};
        for (int i = gt; i < INCP; i += NGT) BIAS[i] = (i < 2464) ? b_in[i] : ((i < 2560) ? 0.f : b_in[i - 96]);
        for (int i = gt; i < NTOK * 16; i += NGT) { const int t = i >> 4, k = i & 15; const float inv = exp2f(-(float)k * 0.83048202372184058f); const float ang = (float)pos[t] * inv;
            CS[(size_t)t * 32 + k] = cosf(ang); CS[(size_t)t * 32 + 16 + k] = sinf(ang); }
        for (int m = gw; m < NTOK; m += NGW) {
            const f32x4* xr = (const f32x4*)(x + (size_t)m * DMOD) + lane; f32x4 v[4]; float s = 0.f;
#pragma unroll
            for (int j = 0; j < 4; ++j) { v[j] = xr[64 * j]; s += (v[j].x + v[j].y) + (v[j].z + v[j].w); }
            const float mean = wave_sum(s) * (1.f / DMOD); float s2 = 0.f;
#pragma unroll
            for (int j = 0; j < 4; ++j) { v[j] = v[j] - mean; s2 += (v[j].x * v[j].x + v[j].y * v[j].y) + (v[j].z * v[j].z + v[j].w * v[j].w); }
            const float rstd = 1.f / sqrtf(wave_sum(s2) * (1.f / DMOD) + LN_EPS);
            if (lane == 0) { STAT[2 * m] = mean; STAT[2 * m + 1] = rstd; }
            u32x2* o8 = (u32x2*)(HB + (size_t)m * DMOD) + lane;
#pragma unroll
            for (int j = 0; j < 4; ++j) { const f32x4 gv = ((const f32x4*)ln_in_g)[lane + 64 * j], bv = ((const f32x4*)ln_in_b)[lane + 64 * j]; const f32x4 hv = v[j] * rstd * gv + bv;
                u32x2 w; w.x = cvt_pk_bf16(hv.x, hv.y); w.y = cvt_pk_bf16(hv.z, hv.w); o8[64 * j] = w; }
        }
        __syncthreads();
    }
    SEAM(0);
    if (IN(1)) {
        pg8::Gemm g{HB, WIN, NTOK, INCP, 1024, 1024, 1024}; pg8::StaticOrder S; S.init(NTOK, INCP, G, bx);
        pg8::EpiProj E{PROJ, BIAS};
        pg8::gemm_phase<pg8::EpiProj>(lds, g, S, E);
    }
    SEAM(1);
    if (IN(2)) {
        PH_IDS
        const int sub = lane >> 4, l16 = lane & 15;
        for (int m0 = gw * 4; m0 < NTOK; m0 += NGW * 4) {
            const int m = m0 + sub; bf16_t* pr = PROJ + (size_t)m * INCP;
            const u32x4 q0 = *((const u32x4*)(pr + C_CQ) + l16), q1 = *((const u32x4*)(pr + C_CQ) + 16 + l16);
            const u32x4 kk = *((const u32x4*)(pr + C_CKV) + l16);
            float x1 = 0.f, x2 = 0.f, cc = 0.f, ss = 0.f;
            { x1 = bf1(pr[C_KR + l16]); x2 = bf1(pr[C_KR + 16 + l16]); cc = CS[(size_t)m * 32 + l16]; ss = CS[(size_t)m * 32 + 16 + l16]; }
            float sq = 0.f, sk = 0.f;
#pragma unroll
            for (int j = 0; j < 4; ++j) { const float a0 = bf_lo(q0[j]), a1 = bf_hi(q0[j]), a2 = bf_lo(q1[j]), a3 = bf_hi(q1[j]), k0 = bf_lo(kk[j]), k1 = bf_hi(kk[j]);
                sq += (a0 * a0 + a1 * a1) + (a2 * a2 + a3 * a3); sk += k0 * k0 + k1 * k1; }
#pragma unroll
            for (int o = 1; o < 16; o <<= 1) { sq += __shfl_xor(sq, o); sk += __shfl_xor(sk, o); }
            const float rq = 1.f / sqrtf(sq * (1.f / 256.f) + RMS_EPS), rk_ = 1.f / sqrtf(sk * (1.f / 128.f) + RMS_EPS);
            u32x4 o0, o1, o2;
#pragma unroll
            for (int j = 0; j < 4; ++j) { o0[j] = cvt_pk_bf16(bf_lo(q0[j]) * rq, bf_hi(q0[j]) * rq); o1[j] = cvt_pk_bf16(bf_lo(q1[j]) * rq, bf_hi(q1[j]) * rq); o2[j] = cvt_pk_bf16(bf_lo(kk[j]) * rk_, bf_hi(kk[j]) * rk_); }
            *((u32x4*)(pr + C_CQ) + l16) = o0; *((u32x4*)(pr + C_CQ) + 16 + l16) = o1; *((u32x4*)(pr + C_CKV) + l16) = o2;
            KPE[(size_t)m * 32 + l16] = (bf16_t)(cvt_pk_bf16(x1 * cc - x2 * ss, 0.f) & 0xffffu); KPE[(size_t)m * 32 + 16 + l16] = (bf16_t)(cvt_pk_bf16(x2 * cc + x1 * ss, 0.f) & 0xffffu);
        }
    }
    SEAM(2);
    if (IN(3)) {
        { pg8::Gemm g{PROJ + C_CQ, WUQ, NTOK, 768, 256, INCP, 256}; pg8::StaticOrder S; S.init(NTOK, 768, G, bx);
          pg8::EpiQ E{QB, RS, CS}; pg8::gemm_phase<pg8::EpiQ>(lds, g, S, E); }
        { pg8::Gemm g{PROJ + C_CKV, WUKV, NTOK, 1024, 256, INCP, 256}; pg8::StaticOrder S; S.init(NTOK, 1024, G, G - 1 - bx);
          pg8::EpiKV E{KB, VB, RS}; pg8::gemm_phase<pg8::EpiKV>(lds, g, S, E); }
    }
    SEAM(3);
    if (IN(4)) {
        att::Ptrs P{PROJ, QB, KB, VB, KPE, YAB, rel_bias};
        if (a.sel & 1) for (int j = vcu; j < 1024; j += G) { const int r = j >> 8, v = j & 255, bh = v >> 3, s = v & 7; const int qb = (r == 0) ? s : (r == 1) ? 15 - s : (r == 2) ? 16 + s : 31 - s;
            att::attn_unit<1>((LAS char*)lds, bh >> 3, bh & 7, qb, P); }
        if (a.sel & 2) for (int j = vcu; j < 1024; j += G) { const int bh = j >> 5, qb = j & 31; att::attn_unit<0>((LAS char*)lds, bh >> 3, bh & 7, qb, P); }
    }
    SEAM(4);
    if (IN(5)) {
        pg8::StaticOrder S; S.init(NTOK, 1024, G, bx);
        { pg8::Gemm g{YAB, WP, NTOK, 1024, 512, 1024, 1024}; pg8::EpiMix<0> E{MIX, PROJ}; pg8::gemm_phase<pg8::EpiMix<0>>(lds, g, S, E); }
        { pg8::Gemm g{YAB + 512, WP + 512, NTOK, 1024, 512, 1024, 1024}; pg8::EpiMix<1> E{MIX, PROJ}; pg8::gemm_phase<pg8::EpiMix<1>>(lds, g, S, E); }
    }
    SEAM(5);
    if (IN(6)) {
        pg8::Gemm g{MIX, WOUT, NTOK, 1024, 1024, 1024, 1024}; pg8::StaticOrder S; S.init(NTOK, 1024, G, bx);
        pg8::EpiOut E{a.out, x, STAT, ln_in_g, ln_in_b, PART}; pg8::gemm_phase<pg8::EpiOut>(lds, g, S, E);
    }
    SEAM(6);
    if (IN(7)) {
        PH_IDS
        f32x4 gv[4], bv[4];
#pragma unroll
        for (int j = 0; j < 4; ++j) { gv[j] = ((const f32x4*)ln_post_g)[lane + 64 * j]; bv[j] = ((const f32x4*)ln_post_b)[lane + 64 * j]; }
        for (int m = gw * 2; m < NTOK; m += NGW * 2) {
            f32x4* xr0 = (f32x4*)(a.out + (size_t)m * DMOD) + lane; f32x4* xr1 = xr0 + 256; f32x4 v0[4], v1[4];
#pragma unroll
            for (int j = 0; j < 4; ++j) { v0[j] = xr0[64 * j]; v1[j] = xr1[64 * j]; }
            const float pp = (lane < 32) ? PART[(size_t)m * 32 + lane] : PART[(size_t)(m + 1) * 32 + (lane - 32)];
            float e = pp;
#pragma unroll
            for (int o = 2; o < 32; o <<= 1) e += __shfl_xor(e, o);
            const float sum0 = __shfl(e, 0), sq0 = __shfl(e, 1), sum1 = __shfl(e, 32), sq1 = __shfl(e, 33);
            const float mean0 = sum0 * (1.f / DMOD), mean1 = sum1 * (1.f / DMOD);
            const float rstd0 = 1.f / sqrtf(fmaxf(sq0 * (1.f / DMOD) - mean0 * mean0, 0.f) + LN_EPS), rstd1 = 1.f / sqrtf(fmaxf(sq1 * (1.f / DMOD) - mean1 * mean1, 0.f) + LN_EPS);
#pragma unroll
            for (int j = 0; j < 4; ++j) { xr0[64 * j] = (v0[j] - mean0) * rstd0 * gv[j] + bv[j]; xr1[64 * j] = (v1[j] - mean1) * rstd1 * gv[j] + bv[j]; }
        }
    }
#undef IN
#undef SEAM
}

extern "C" void kernel_launch(void* const* d_in, const int* in_sizes, int n_in, void* d_out, int out_size, void* d_ws, size_t ws_size, hipStream_t stream) {
    static int grid = 0;
    if (grid == 0) {
        if (n_in != 16 || out_size != NTOK * DMOD || ws_size < WS_END) { fprintf(stderr, "kernel_launch: unexpected shapes (n_in %d, out %d, ws %zu)\n", n_in, out_size, ws_size); grid = -1; return; }
        int dev = 0, cus = 0, per_cu = 0;
        hipGetDevice(&dev); hipDeviceGetAttribute(&cus, hipDeviceAttributeMultiprocessorCount, dev);
        hipFuncSetAttribute((const void*)fwd, hipFuncAttributeMaxDynamicSharedMemorySize, LDS_BYTES);
        hipOccupancyMaxActiveBlocksPerMultiprocessor(&per_cu, (const void*)fwd, 512, LDS_BYTES);
        (void)hipGetLastError();
        if (per_cu < 1) per_cu = 1;
        grid = cus;
        if (grid > cus * per_cu) grid = cus * per_cu;
    }
    if (grid < 0) return;
    hipMemsetAsync(d_ws, 0, 4096, stream);
    Args a{};
    for (int i = 0; i < 16; ++i) a.in[i] = d_in[i];
    a.out = (float*)d_out; a.ws = (unsigned char*)d_ws;
    a.sel = 3;
#if defined(PROBE_PHASE)
    { Args pa = a; pa.lo = PROBE_PHASE; pa.hi = PROBE_PHASE + 1; pa.sel = PROBE_SEL; hipLaunchKernelGGL(fwd, dim3(grid), dim3(512), LDS_BYTES, stream, pa); }
#endif
#if ONE_LAUNCH
    a.lo = 0; a.hi = NPH;
    void* args[] = {&a};
    hipError_t e = hipLaunchCooperativeKernel((const void*)fwd, dim3(grid), dim3(512), args, LDS_BYTES, stream);
    if (e != hipSuccess) fprintf(stderr, "cooperative launch failed: %s (grid %d)\n", hipGetErrorString(e), grid);
#else
    for (int p = 0; p < NPH; ++p) { a.lo = p; a.hi = p + 1; hipLaunchKernelGGL(fwd, dim3(grid), dim3(512), LDS_BYTES, stream, a); }
#endif
}
```

```cpp
#include <hip/hip_runtime.h>
#include <hip/hip_cooperative_groups.h>
#include <cstdio>
#include <cstdint>
namespace cg = cooperative_groups;

#ifndef MIX_ONE
#define MIX_ONE 0
#endif
#ifndef ONE_LAUNCH
#define ONE_LAUNCH 1
#endif

#define LAS __attribute__((address_space(3)))
typedef unsigned short bf16_t;
typedef short bf16x8 __attribute__((ext_vector_type(8)));
typedef short s16x4 __attribute__((ext_vector_type(4)));
typedef float f32x2 __attribute__((ext_vector_type(2)));
typedef float f32x4 __attribute__((ext_vector_type(4)));
typedef float f32x16 __attribute__((ext_vector_type(16)));
typedef unsigned u32x2 __attribute__((ext_vector_type(2)));
typedef unsigned u32x4 __attribute__((ext_vector_type(4)));
typedef int i32x4 __attribute__((ext_vector_type(4)));
typedef int i32x8 __attribute__((ext_vector_type(8)));

constexpr int NTOK = 32768, DMOD = 1024, SEQ = 8192;
constexpr int INC = 5024, INCP = 5120;
constexpr int C_AQ = 0, C_AK = 512, C_AV = 1024, C_AZ = 1536, C_CQ = 2048, C_CKV = 2304, C_KR = 2432, C_BZ = 2560, C_GA = 3072, C_GB = 4096;
constexpr float LOG2E = 1.4426950408889634f;
constexpr float C2A = 0.125f * LOG2E;
constexpr float C2B = 0.10206207261596575f * LOG2E;
constexpr float ALPHA = 1.189207115002721f;
constexpr float LN_EPS = 1e-5f, RMS_EPS = 1e-6f;

constexpr size_t MiB = 1u << 20;
constexpr size_t WS_BIAS = 1 * MiB;
constexpr size_t WS_STAT = 2 * MiB;
constexpr size_t WS_RS = 2 * MiB + 512 * 1024;
constexpr size_t WS_WUQ = 3 * MiB;
constexpr size_t WS_WUKV = 3 * MiB + 512 * 1024;
constexpr size_t WS_WP = 4 * MiB;
constexpr size_t WS_WOUT = 6 * MiB;
constexpr size_t WS_CS = 8 * MiB;
constexpr size_t WS_WIN = 12 * MiB;
constexpr size_t WS_KPE = 22 * MiB;
constexpr size_t WS_HB = 24 * MiB;
constexpr size_t WS_QB = 24 * MiB;
constexpr size_t WS_KB = 88 * MiB;
constexpr size_t WS_VB = 120 * MiB;
constexpr size_t WS_MIX = 88 * MiB;
constexpr size_t WS_PROJ = 152 * MiB;
constexpr size_t WS_PART = 24 * MiB;
constexpr size_t WS_END = 472 * MiB;

__device__ __forceinline__ unsigned cvt_pk_bf16(float lo, float hi) { unsigned r; asm volatile("v_cvt_pk_bf16_f32 %0, %1, %2" : "=v"(r) : "v"(lo), "v"(hi)); return r; }
__device__ __forceinline__ float bf_lo(unsigned w) { return __uint_as_float(w << 16); }
__device__ __forceinline__ float bf_hi(unsigned w) { return __uint_as_float(w & 0xffff0000u); }
__device__ __forceinline__ float bf1(bf16_t b) { return __uint_as_float(((unsigned)b) << 16); }
__device__ __forceinline__ float wave_sum(float v) {
#pragma unroll
    for (int o = 1; o < 64; o <<= 1) v += __shfl_xor(v, o);
    return v;
}
__device__ __forceinline__ float sigmoidf_(float x) { return __builtin_amdgcn_rcpf(1.0f + __builtin_amdgcn_exp2f(-x * LOG2E)); }
#define LDS_WAIT() asm volatile("s_waitcnt lgkmcnt(0)" ::: "memory")

namespace pg8 {
constexpr int BM = 256, BK = 64, HALF = 128, HTB = HALF * BK * 2, STAGE_BYTES = 8 * HTB, NXCD = 8, WGM = 8;
__host__ __device__ __forceinline__ int lds_byte(int r, int c) { const int st = (r >> 4) * 2 + (c >> 5), rr = r & 15, cc = c & 31, ob = rr * 64 + cc * 2; return st * 1024 + (ob ^ (((ob >> 9) & 1) << 5)); }
__host__ __device__ __forceinline__ void stage_rc(int b, int& R, int& C) { const int st = b / 1024, sb = b % 1024, swz = sb ^ (((sb >> 9) & 1) << 5); R = (st >> 1) * 16 + swz / 64; C = (st & 1) * 32 + (swz % 64) / 2; }
__host__ __device__ __forceinline__ int perm32(int rho) { const int n = rho >> 4, i = rho & 15; return 8 * (i >> 2) + 4 * n + (i & 3); }

struct Unit { int pm, pn; };
struct Gemm { const bf16_t* A; const bf16_t* Bt; int M, N, K, lda, ldb; };

struct StaticOrder {
    int nM, nN, nwg, G, c;
    __device__ void init(int M, int N, int G_, int c_) { nM = M / BM; nN = N / BM; nwg = nM * nN; G = G_; c = c_; }
    __device__ bool next(int i, Unit& u) const {
        const long L = (long)i * G + c; if (L >= nwg) return false;
        int wgid = (int)L; { const int q = nwg / NXCD, r = nwg % NXCD, xcd = wgid % NXCD, off = wgid / NXCD; wgid = (xcd < r ? xcd * (q + 1) : r * (q + 1) + (xcd - r) * q) + off; }
        const int nig = WGM * nN, gid = wgid / nig, fm = gid * WGM, gsz = (nM - fm) < WGM ? (nM - fm) : WGM;
        u.pm = fm + ((wgid % nig) % gsz); u.pn = (wgid % nig) / gsz; return true;
    }
};

typedef f32x4 Acc[2][2][4][2];

struct EpiProj {
    static constexpr bool PERM = true; static constexpr int MID_T = -1;
    bf16_t* O; const float* bias;
    __device__ __forceinline__ void mid(Acc&, const Unit&, int, int, int, int) const {}
    __device__ __forceinline__ void operator()(const Acc& acc, const Unit& u, int wr, int wc, int fr, int fq) const {
        const int row0 = u.pm * BM + wr * 64 + fr; const int col0 = u.pn * BM + wc * 32 + 8 * fq;
        const float sc = (u.pn < 2) ? C2A : 1.0f;
        const int actm = (u.pn >= 12) ? 2 : ((u.pn == 6 || u.pn == 7 || u.pn == 10 || u.pn == 11) ? 1 : 0);
        f32x4 bv[2][2];
#pragma unroll
        for (int bj = 0; bj < 2; ++bj)
#pragma unroll
            for (int n = 0; n < 2; ++n) bv[bj][n] = *(const f32x4*)(bias + col0 + bj * HALF + 4 * n);
#pragma unroll
        for (int ai = 0; ai < 2; ++ai)
#pragma unroll
            for (int m = 0; m < 4; ++m) { bf16_t* rowp = O + (size_t)(row0 + ai * HALF + m * 16) * INCP + col0;
#pragma unroll
                for (int bj = 0; bj < 2; ++bj) { f32x4 v0 = (acc[ai][bj][m][0] * 0.03125f + bv[bj][0]) * sc, v1 = (acc[ai][bj][m][1] * 0.03125f + bv[bj][1]) * sc;
                    if (actm) {
#pragma unroll
                        for (int j = 0; j < 4; ++j) { const float s0 = sigmoidf_(v0[j]), s1 = sigmoidf_(v1[j]); v0[j] = (actm == 2) ? s0 : v0[j] * s0; v1[j] = (actm == 2) ? s1 : v1[j] * s1; } }
                    u32x4 w; w.x = cvt_pk_bf16(v0[0], v0[1]); w.y = cvt_pk_bf16(v0[2], v0[3]); w.z = cvt_pk_bf16(v1[0], v1[1]); w.w = cvt_pk_bf16(v1[2], v1[3]);
                    *(u32x4*)(rowp + bj * HALF) = w; } }
    }
};
struct EpiKV {
    static constexpr bool PERM = true; static constexpr int MID_T = -1;
    bf16_t* KBp; bf16_t* VBp; const float* rs;
    __device__ __forceinline__ void mid(Acc&, const Unit&, int, int, int, int) const {}
    __device__ __forceinline__ void operator()(const Acc& acc, const Unit& u, int wr, int wc, int fr, int fq) const {
        const int row0 = u.pm * BM + wr * 64 + fr; int colt = u.pn * BM; bf16_t* base = KBp; if (colt >= 512) { base = VBp; colt -= 512; }
        const int col0 = colt + wc * 32 + 8 * fq;
#pragma unroll
        for (int ai = 0; ai < 2; ++ai)
#pragma unroll
            for (int m = 0; m < 4; ++m) { const int row = row0 + ai * HALF + m * 16; bf16_t* rowp = base + (size_t)row * 512 + col0;
#pragma unroll
                for (int bj = 0; bj < 2; ++bj) { const f32x4 v0 = acc[ai][bj][m][0], v1 = acc[ai][bj][m][1];
                    u32x4 w; w.x = cvt_pk_bf16(v0[0], v0[1]); w.y = cvt_pk_bf16(v0[2], v0[3]); w.z = cvt_pk_bf16(v1[0], v1[1]); w.w = cvt_pk_bf16(v1[2], v1[3]);
                    *(u32x4*)(rowp + bj * HALF) = w; } }
    }
};
struct EpiQ {
    static constexpr bool PERM = false; static constexpr int MID_T = -1;
    bf16_t* QBp; const float* rs; const float* cs;
    __device__ __forceinline__ void mid(Acc&, const Unit&, int, int, int, int) const {}
    __device__ __forceinline__ void operator()(const Acc& acc, const Unit& u, int wr, int wc, int fr, int fq) const {
        const int row0 = u.pm * BM + wr * 64 + fr;
#pragma unroll
        for (int bj = 0; bj < 2; ++bj) { const int cb = u.pn * BM + bj * HALF + wc * 32; const bool rope = ((cb >> 5) % 3) == 2;
#pragma unroll
            for (int ai = 0; ai < 2; ++ai) {
                f32x4 cv[4], sv[4];
                if (rope) {
#pragma unroll
                    for (int m = 0; m < 4; ++m) { const int row = row0 + ai * HALF + m * 16; cv[m] = *(const f32x4*)(cs + (size_t)row * 32 + 4 * fq); sv[m] = *(const f32x4*)(cs + (size_t)row * 32 + 16 + 4 * fq); } }
#pragma unroll
                for (int m = 0; m < 4; ++m) { const int row = row0 + ai * HALF + m * 16;
                    f32x4 x1 = acc[ai][bj][m][0] * C2B, x2 = acc[ai][bj][m][1] * C2B;
                    if (rope) { const f32x4 o1 = x1 * cv[m] - x2 * sv[m], o2 = x2 * cv[m] + x1 * sv[m]; x1 = o1; x2 = o2; }
                    u32x2 w1, w2; w1.x = cvt_pk_bf16(x1[0], x1[1]); w1.y = cvt_pk_bf16(x1[2], x1[3]); w2.x = cvt_pk_bf16(x2[0], x2[1]); w2.y = cvt_pk_bf16(x2[2], x2[3]);
                    bf16_t* p = QBp + (size_t)row * 768 + cb + 4 * fq;
                    *(u32x2*)p = w1; *(u32x2*)(p + 16) = w2; }
                asm volatile("" ::: "memory"); } }
    }
};
template <int SECOND> struct EpiMix {
    static constexpr bool PERM = true; static constexpr int MID_T = -1;
    bf16_t* MIXp; const bf16_t* PROJp;
    __device__ __forceinline__ void mid(Acc&, const Unit&, int, int, int, int) const {}
    __device__ __forceinline__ void operator()(const Acc& acc, const Unit& u, int wr, int wc, int fr, int fq) const {
        const int row0 = u.pm * BM + wr * 64 + fr; const int col0 = u.pn * BM + wc * 32 + 8 * fq;
#pragma unroll
        for (int ai = 0; ai < 2; ++ai) {
            u32x4 gt[4][2], pv[4][2];
#pragma unroll
            for (int m = 0; m < 4; ++m) { const size_t row = (size_t)(row0 + ai * HALF + m * 16); const bf16_t* rowp = PROJp + row * INCP + col0 + (SECOND ? C_GB : C_GA);
#pragma unroll
                for (int bj = 0; bj < 2; ++bj) { gt[m][bj] = *(const u32x4*)(rowp + bj * HALF); pv[m][bj] = (u32x4){0u, 0u, 0u, 0u};
                    if (SECOND) pv[m][bj] = *(const u32x4*)(MIXp + row * DMOD + col0 + bj * HALF); } }
#pragma unroll
            for (int m = 0; m < 4; ++m) { const size_t row = (size_t)(row0 + ai * HALF + m * 16);
#pragma unroll
                for (int bj = 0; bj < 2; ++bj) { float o[8];
#pragma unroll
                    for (int j = 0; j < 4; ++j) { o[2 * j] = bf_lo(pv[m][bj][j]) + acc[ai][bj][m][j >> 1][(j & 1) * 2] * bf_lo(gt[m][bj][j]); o[2 * j + 1] = bf_hi(pv[m][bj][j]) + acc[ai][bj][m][j >> 1][(j & 1) * 2 + 1] * bf_hi(gt[m][bj][j]); }
                    u32x4 w; w.x = cvt_pk_bf16(o[0], o[1]); w.y = cvt_pk_bf16(o[2], o[3]); w.z = cvt_pk_bf16(o[4], o[5]); w.w = cvt_pk_bf16(o[6], o[7]);
                    *(u32x4*)(MIXp + row * DMOD + col0 + bj * HALF) = w; } }
            asm volatile("" ::: "memory"); }
    }
};
struct EpiMix1 {
    static constexpr bool PERM = true; static constexpr int MID_T = 8;
    bf16_t* MIXp; const bf16_t* PROJp;
    __device__ __forceinline__ void mid(Acc& acc, const Unit& u, int wr, int wc, int fr, int fq) const {
        const int row0 = u.pm * BM + wr * 64 + fr; const int col0 = u.pn * BM + wc * 32 + 8 * fq;
#pragma unroll
        for (int ai = 0; ai < 2; ++ai)
#pragma unroll
            for (int m = 0; m < 4; ++m) { const bf16_t* rowp = PROJp + (size_t)(row0 + ai * HALF + m * 16) * INCP + col0;
#pragma unroll
                for (int bj = 0; bj < 2; ++bj) { const u32x4 ga = *(const u32x4*)(rowp + C_GA + bj * HALF), gb = *(const u32x4*)(rowp + C_GB + bj * HALF);
#pragma unroll
                    for (int j = 0; j < 4; ++j) { const float r0 = bf_lo(ga[j]) * __builtin_amdgcn_rcpf(bf_lo(gb[j])), r1 = bf_hi(ga[j]) * __builtin_amdgcn_rcpf(bf_hi(gb[j]));
                        acc[ai][bj][m][j >> 1][(j & 1) * 2] *= r0; acc[ai][bj][m][j >> 1][(j & 1) * 2 + 1] *= r1; } }
                asm volatile("" ::: "memory"); }
    }
    __device__ __forceinline__ void operator()(const Acc& acc, const Unit& u, int wr, int wc, int fr, int fq) const {
        const int row0 = u.pm * BM + wr * 64 + fr; const int col0 = u.pn * BM + wc * 32 + 8 * fq;
#pragma unroll
        for (int ai = 0; ai < 2; ++ai)
#pragma unroll
            for (int m = 0; m < 4; ++m) { const size_t row = (size_t)(row0 + ai * HALF + m * 16); const bf16_t* rowp = PROJp + row * INCP + col0 + C_GB;
#pragma unroll
                for (int bj = 0; bj < 2; ++bj) { const u32x4 gb = *(const u32x4*)(rowp + bj * HALF); float o[8];
#pragma unroll
                    for (int j = 0; j < 4; ++j) { o[2 * j] = acc[ai][bj][m][j >> 1][(j & 1) * 2] * bf_lo(gb[j]); o[2 * j + 1] = acc[ai][bj][m][j >> 1][(j & 1) * 2 + 1] * bf_hi(gb[j]); }
                    u32x4 w; w.x = cvt_pk_bf16(o[0], o[1]); w.y = cvt_pk_bf16(o[2], o[3]); w.z = cvt_pk_bf16(o[4], o[5]); w.w = cvt_pk_bf16(o[6], o[7]);
                    *(u32x4*)(MIXp + row * DMOD + col0 + bj * HALF) = w; }
                asm volatile("" ::: "memory"); }
    }
};
struct EpiOut {
    static constexpr bool PERM = false; static constexpr int MID_T = -1;
    float* Y; const float* X; const float* stat; const float* g; const float* b; float* part;
    __device__ __forceinline__ void mid(Acc&, const Unit&, int, int, int, int) const {}
    __device__ __forceinline__ void operator()(const Acc& acc, const Unit& u, int wr, int wc, int fr, int fq) const {
        const int row0 = u.pm * BM + wr * 64 + fr; const int col0 = u.pn * BM + wc * 32 + 4 * fq;
#pragma unroll
        for (int ai = 0; ai < 2; ++ai)
#pragma unroll
            for (int mp = 0; mp < 2; ++mp) {
                f32x4 xv[2][2][2]; f32x2 st[2];
#pragma unroll
                for (int mm = 0; mm < 2; ++mm) { const size_t row = (size_t)(row0 + ai * HALF + (2 * mp + mm) * 16); st[mm] = *(const f32x2*)(stat + 2 * row);
#pragma unroll
                    for (int bj = 0; bj < 2; ++bj)
#pragma unroll
                        for (int n = 0; n < 2; ++n) xv[mm][bj][n] = *(const f32x4*)(X + row * DMOD + col0 + bj * HALF + n * 16); }
#pragma unroll
                for (int mm = 0; mm < 2; ++mm) { const int m = 2 * mp + mm; const size_t row = (size_t)(row0 + ai * HALF + m * 16); const size_t off = row * DMOD + col0;
                    float s1 = 0.f, s2 = 0.f;
#pragma unroll
                    for (int bj = 0; bj < 2; ++bj)
#pragma unroll
                        for (int n = 0; n < 2; ++n) { const f32x4 gv = *(const f32x4*)(g + col0 + bj * HALF + n * 16) * ALPHA, bv = *(const f32x4*)(b + col0 + bj * HALF + n * 16) * ALPHA;
                            const f32x4 o = ((xv[mm][bj][n] - st[mm].x) * st[mm].y) * gv + bv + acc[ai][bj][m][n];
                            s1 += (o[0] + o[1]) + (o[2] + o[3]); s2 += (o[0] * o[0] + o[1] * o[1]) + (o[2] * o[2] + o[3] * o[3]);
                            *(f32x4*)(Y + off + bj * HALF + n * 16) = o; }
                    s1 += __shfl_xor(s1, 16); s1 += __shfl_xor(s1, 32); s2 += __shfl_xor(s2, 16); s2 += __shfl_xor(s2, 32);
                    if (fq == 0) *(f32x2*)(part + row * 32 + (u.pn * 4 + wc) * 2) = (f32x2){s1, s2}; }
                asm volatile("" ::: "memory"); }
    }
};

template <class Epi, bool ALIGN_EPI = true, bool SP2 = true, bool FP8 = false>
__device__ __forceinline__ void gemm_phase(LAS unsigned char* lds, const Gemm g, const StaticOrder& S, const Epi& E) {
    const int tid = threadIdx.x, wid = __builtin_amdgcn_readfirstlane(tid >> 6), lane = tid & 63, wr = wid >> 2, wc = wid & 3, fr = lane & 15, fq = lane >> 4;
    const int K = g.K, nt = K / BK;
    unsigned voffA[2], voffB[2];
#pragma unroll
    for (int i = 0; i < 2; ++i) { int R, C; stage_rc(tid * 16 + i * 8192, R, C); const int Rb = Epi::PERM ? ((R & ~31) + perm32(R & 31)) : R;
        voffA[i] = (unsigned)(R * g.lda + C) * 2u; voffB[i] = (unsigned)(Rb * g.ldb + C) * 2u; }
    const size_t kstep = (size_t)(BK * 2);
    const size_t hsA = (size_t)HALF * g.lda * 2, hsB = (size_t)HALF * g.ldb * 2;
    const size_t tsA = 2 * hsA, tsB = 2 * hsB;
    const unsigned ldsw = (unsigned)wid * 1024u;
    const int aoff = lds_byte(wr * 64 + fr, fq * 8), boff = lds_byte(wc * 32 + fr, fq * 8);
#define PG8_SA(b, h) (((b) * 2 + (h)) * HTB)
#define PG8_SB(b, h) ((4 + (b) * 2 + (h)) * HTB)
#define PG8_STAGE(bufoff, gbase, voff) do { _Pragma("unroll") for (int _i = 0; _i < 2; ++_i) \
        __builtin_amdgcn_global_load_lds((const unsigned*)((const char*)(gbase) + (voff)[_i]), (LAS unsigned*)(lds + (bufoff) + ldsw + _i * 8192), 16, 0, 0); } while (0)
#define PG8_LDA(dst, b, h) do { _Pragma("unroll") for (int m = 0; m < 4; ++m) _Pragma("unroll") for (int k = 0; k < 2; ++k) dst[m][k] = *(const LAS bf16x8*)(lds + PG8_SA(b, h) + aoff + m * 2048 + k * 1024); } while (0)
#define PG8_LDB(dst, b, h) do { _Pragma("unroll") for (int n = 0; n < 2; ++n) _Pragma("unroll") for (int k = 0; k < 2; ++k) dst[n][k] = *(const LAS bf16x8*)(lds + PG8_SB(b, h) + boff + n * 2048 + k * 1024); } while (0)
#define PG8_CAT(x0, x1) __builtin_shufflevector(__builtin_bit_cast(i32x4, x0), __builtin_bit_cast(i32x4, x1), 0, 1, 2, 3, 4, 5, 6, 7)
#define PG8_MMA(ai, bj, At, Bt) do { __builtin_amdgcn_s_setprio(1); _Pragma("unroll") for (int m = 0; m < 4; ++m) _Pragma("unroll") for (int n = 0; n < 2; ++n) { \
        if constexpr (FP8) { asm volatile("v_mfma_scale_f32_16x16x128_f8f6f4 %0, %1, %2, %0, %3, %3 op_sel_hi:[0,0,0]" : "+v"(acc[ai][bj][m][n]) : "v"(PG8_CAT(Bt[n][0], Bt[n][1])), "v"(PG8_CAT(At[m][0], At[m][1])), "v"(one_scale)); } \
        else { _Pragma("unroll") for (int k = 0; k < 2; ++k) acc[ai][bj][m][n] = __builtin_amdgcn_mfma_f32_16x16x32_bf16(Bt[n][k], At[m][k], acc[ai][bj][m][n], 0, 0, 0); } } __builtin_amdgcn_s_setprio(0); } while (0)
#define PG8_WAIT_V(n) asm volatile("s_waitcnt vmcnt(" #n ")" ::: "memory")
#define PG8_WAIT_L(n) asm volatile("s_waitcnt lgkmcnt(" #n ")" ::: "memory")
#define PG8_BAR __builtin_amdgcn_s_barrier()
#define PG8_SCHED __builtin_amdgcn_sched_barrier(0)
    Unit cur, nxt; int ui = 0;
    if (!S.next(0, cur)) return;
    int one_scale = 0x7f7f7f7f; asm volatile("" : "+v"(one_scale));
    Acc acc;
#pragma unroll
    for (int a = 0; a < 2; ++a)
#pragma unroll
        for (int b = 0; b < 2; ++b)
#pragma unroll
            for (int m = 0; m < 4; ++m)
#pragma unroll
                for (int n = 0; n < 2; ++n) acc[a][b][m][n] = (f32x4){0.f, 0.f, 0.f, 0.f};
    bf16x8 At[4][2], B0[2][2], B1[2][2];
    const char* cA = (const char*)g.A + (size_t)cur.pm * tsA; const char* cB = (const char*)g.Bt + (size_t)cur.pn * tsB;
    if constexpr (SP2) {
        PG8_STAGE(PG8_SB(0, 0), cB, voffB); PG8_STAGE(PG8_SB(0, 1), cB + hsB, voffB); PG8_STAGE(PG8_SA(0, 0), cA, voffA); PG8_STAGE(PG8_SA(0, 1), cA + hsA, voffA);
        if (wr == 1) PG8_BAR;
        PG8_WAIT_V(2); PG8_BAR;
        PG8_STAGE(PG8_SB(1, 0), cB + kstep, voffB); PG8_STAGE(PG8_SA(1, 0), cA + kstep, voffA); PG8_STAGE(PG8_SB(1, 1), cB + hsB + kstep, voffB);
        PG8_WAIT_V(6); PG8_BAR;
    }
    for (;;) {
        const bool has_next = S.next(ui + 1, nxt);
        const char* nA = has_next ? (const char*)g.A + (size_t)nxt.pm * tsA : cA; const char* nB = has_next ? (const char*)g.Bt + (size_t)nxt.pn * tsB : cB;
#pragma unroll 1
        for (int t = 0; t < nt; t += 2) {
            const bool last = (t == nt - 2);
            const char* a1 = cA + (size_t)(t + 1) * kstep;
            const char* a2 = last ? nA : cA + (size_t)(t + 2) * kstep; const char* b2 = last ? nB : cB + (size_t)(t + 2) * kstep;
            const char* a3 = a2 + kstep; const char* b3 = b2 + kstep;
            if constexpr (Epi::MID_T >= 0) { if (t == Epi::MID_T) E.mid(acc, cur, wr, wc, fr, fq); }
            PG8_LDB(B0, 0, 0); PG8_LDB(B1, 0, 1); PG8_SCHED; PG8_LDA(At, 0, 0); PG8_STAGE(PG8_SA(1, 1), a1 + hsA, voffA);
            PG8_WAIT_V(8); PG8_WAIT_L(0); PG8_BAR; PG8_MMA(0, 0, At, B0); PG8_MMA(0, 1, At, B1); PG8_BAR; PG8_SCHED;
            PG8_LDA(At, 0, 1); PG8_STAGE(PG8_SB(0, 0), b2, voffB); PG8_STAGE(PG8_SB(0, 1), b2 + hsB, voffB); PG8_STAGE(PG8_SA(0, 0), a2, voffA);
            PG8_WAIT_V(8); PG8_WAIT_L(0); PG8_BAR; PG8_MMA(1, 0, At, B0); PG8_MMA(1, 1, At, B1); PG8_BAR; PG8_SCHED;
            PG8_LDB(B0, 1, 0); PG8_LDB(B1, 1, 1); PG8_SCHED; PG8_LDA(At, 1, 0); PG8_STAGE(PG8_SA(0, 1), a2 + hsA, voffA);
            PG8_WAIT_V(8); PG8_WAIT_L(0); PG8_BAR; PG8_MMA(0, 0, At, B0); PG8_MMA(0, 1, At, B1); PG8_BAR; PG8_SCHED;
            PG8_LDA(At, 1, 1); PG8_STAGE(PG8_SB(1, 0), b3, voffB); PG8_STAGE(PG8_SB(1, 1), b3 + hsB, voffB); PG8_STAGE(PG8_SA(1, 0), a3, voffA);
            PG8_WAIT_V(8); PG8_WAIT_L(0); PG8_BAR; PG8_MMA(1, 0, At, B0); PG8_MMA(1, 1, At, B1); PG8_BAR; PG8_SCHED;
        }
        if constexpr (ALIGN_EPI) { if (wr == 0) PG8_BAR; }
        if constexpr (FP8) asm volatile("s_nop 15\n\ts_nop 15" ::: "memory");
        E(acc, cur, wr, wc, fr, fq);
        if (!has_next) break;
#pragma unroll
        for (int a = 0; a < 2; ++a)
#pragma unroll
            for (int b = 0; b < 2; ++b)
#pragma unroll
                for (int m = 0; m < 4; ++m)
#pragma unroll
                    for (int n = 0; n < 2; ++n) acc[a][b][m][n] = (f32x4){0.f, 0.f, 0.f, 0.f};
        cur = nxt; cA = nA; cB = nB; ++ui;
        if constexpr (ALIGN_EPI) { if (wr == 1) PG8_BAR; }
    }
    PG8_WAIT_V(0);
    if constexpr (!ALIGN_EPI) { if (wr == 0) PG8_BAR; }
    PG8_BAR;
#undef PG8_SA
#undef PG8_SB
#undef PG8_STAGE
#undef PG8_LDA
#undef PG8_LDB
#undef PG8_MMA
#undef PG8_CAT
#undef PG8_WAIT_V
#undef PG8_WAIT_L
#undef PG8_BAR
#undef PG8_SCHED
}
}

namespace att {
constexpr int KOFF = 0, KSLOT = 12288, VOFF = 24576, VSLOT = 8192, WSF = 40960, OST = 43008, TAB = 75776, LDS_END = 77824;
constexpr float THR = 8.0f;
__device__ __forceinline__ int crow(int r, int hi) { return (r & 3) + 8 * (r >> 2) + 4 * hi; }
typedef short v4i16_t __attribute__((ext_vector_type(4)));
__device__ __forceinline__ s16x4 vtr(const LAS char* p) { return __builtin_bit_cast(s16x4, __builtin_amdgcn_ds_read_tr16_b64_v4i16((LAS v4i16_t*)p)); }

struct Ptrs { const bf16_t* PROJ; const bf16_t* QB; const bf16_t* KB; const bf16_t* VB; const bf16_t* KPE; bf16_t* YAB; const float* relb; };

__device__ __forceinline__ float max3_(float a, float b, float c) { return fmaxf(fmaxf(a, b), c); }
__device__ __forceinline__ float xhalf_max(float v) { auto rr = __builtin_amdgcn_permlane32_swap(__float_as_uint(v), __float_as_uint(v), false, false); return fmaxf(__uint_as_float(rr[0]), __uint_as_float(rr[1])); }
__device__ __forceinline__ float xhalf_sum(float v) { auto rr = __builtin_amdgcn_permlane32_swap(__float_as_uint(v), __float_as_uint(v), false, false); return __uint_as_float(rr[0]) + __uint_as_float(rr[1]); }

template <int MODE, bool DO_Q, bool DO_S>
__device__ __forceinline__ void att_step(const LAS char* kb, const LAS char* vp, const bf16x8 (&qr)[MODE ? 6 : 4], f32x16& pc0, f32x16& pc1, f32x16& pn0, f32x16& pn1, f32x16& o0, f32x16& o1,
                                         float& l_run, float nm, int dt, int ql, int hi, const LAS float* tab) {
    constexpr int ND0 = MODE ? 6 : 4;
    if (DO_Q) {
        if (MODE == 0) {
            if (dt >= 3) { const float bc = nm + tab[256];
#pragma unroll
                for (int r = 0; r < 16; ++r) { pn0[r] = bc; pn1[r] = bc; } }
            else {
#pragma unroll
                for (int r = 0; r < 16; ++r) { const int d0_ = 64 * dt + ql - crow(r, hi); const int i0 = (d0_ < 128 ? d0_ : 128) + 128; const int d1_ = d0_ - 32; const int i1 = (d1_ < 128 ? d1_ : 128) + 128;
                    pn0[r] = nm + tab[i0]; pn1[r] = nm + tab[i1]; } }
        } else {
#pragma unroll
            for (int r = 0; r < 16; ++r) { pn0[r] = nm; pn1[r] = nm; } }
#pragma unroll
        for (int d0 = 0; d0 < ND0; ++d0) {
            const bf16x8 a0 = *(const LAS bf16x8*)(kb + d0 * 2048), a1 = *(const LAS bf16x8*)(kb + d0 * 2048 + 512);
            pn0 = __builtin_amdgcn_mfma_f32_32x32x16_bf16(a0, qr[d0], pn0, 0, 0, 0);
            pn1 = __builtin_amdgcn_mfma_f32_32x32x16_bf16(a1, qr[d0], pn1, 0, 0, 0);
        }
    }
    if (DO_S) {
        float s0 = 0.f;
#pragma unroll
        for (int r = 0; r < 16; ++r) { pc0[r] = __builtin_amdgcn_exp2f(pc0[r]); pc1[r] = __builtin_amdgcn_exp2f(pc1[r]); s0 += pc0[r]; s0 += pc1[r]; }
        l_run += s0;
        u32x4 pw[4];
#pragma unroll
        for (int j = 0; j < 4; ++j) { pw[0][j] = cvt_pk_bf16(pc0[2 * j], pc0[2 * j + 1]); pw[1][j] = cvt_pk_bf16(pc0[8 + 2 * j], pc0[9 + 2 * j]);
            pw[2][j] = cvt_pk_bf16(pc1[2 * j], pc1[2 * j + 1]); pw[3][j] = cvt_pk_bf16(pc1[8 + 2 * j], pc1[9 + 2 * j]); }
#pragma unroll
        for (int ks = 0; ks < 4; ++ks) {
            const s16x4 l0 = vtr(vp + ks * 1024), h0 = vtr(vp + ks * 1024 + 512), l1 = vtr(vp + 4096 + ks * 1024), h1 = vtr(vp + 4096 + ks * 1024 + 512);
            const bf16x8 b0 = (bf16x8){l0[0], l0[1], l0[2], l0[3], h0[0], h0[1], h0[2], h0[3]}, b1 = (bf16x8){l1[0], l1[1], l1[2], l1[3], h1[0], h1[1], h1[2], h1[3]};
            const bf16x8 pa = __builtin_bit_cast(bf16x8, pw[ks]);
            o0 = __builtin_amdgcn_mfma_f32_32x32x16_bf16(pa, b0, o0, 0, 0, 0);
            o1 = __builtin_amdgcn_mfma_f32_32x32x16_bf16(pa, b1, o1, 0, 0, 0);
        }
    }
}

template <int MODE>
__device__ __forceinline__ void attn_unit(LAS char* lds, int b, int h, int qb, const Ptrs& P) {
    constexpr int ND0 = MODE ? 6 : 4;
    const int tid = threadIdx.x, lane = tid & 63, r32 = lane & 31, hi = lane >> 5; const int wid = __builtin_amdgcn_readfirstlane(tid >> 6);
    const size_t rowbase = (size_t)b * SEQ; const int q0 = qb * 256;
    const size_t qrow = rowbase + q0 + wid * 32 + r32;
    const bf16_t* Qp = MODE ? (P.QB + qrow * 768 + h * 96) : (P.PROJ + qrow * INCP + C_AQ + h * 64);
    bf16x8 qr[ND0];
#pragma unroll
    for (int d0 = 0; d0 < ND0; ++d0) qr[d0] = *(const bf16x8*)(Qp + d0 * 16 + hi * 8);
    const int cw = 4 * qb + (wid >> 1);
    const int t_first = MODE ? 0 : ((4 * qb - 8) > 0 ? (4 * qb - 8) : 0), t_last = 4 * qb + 3;
    const int w_lo = MODE ? 0 : (cw - 8);
    const size_t ldk = MODE ? 512 : INCP;
    const int vkey = 16 * (wid & 3) + (lane >> 2);
    const bf16_t* ksrc = (MODE ? (P.KB + (rowbase + lane) * 512 + h * 64) : (P.PROJ + (rowbase + lane) * INCP + C_AK + h * 64)) + wid * 8;
    const bf16_t* vsrc = (MODE ? (P.VB + (rowbase + vkey) * 512 + h * 64) : (P.PROJ + (rowbase + vkey) * INCP + C_AV + h * 64)) + (wid >> 2) * 32 + (lane & 3) * 8;
    const bf16_t* psrc = P.KPE + (rowbase + lane) * 32 + (wid & 3) * 8;
    LAS float* wsf = (LAS float*)(lds + WSF + wid * 256);
    LAS float* tab = (LAS float*)(lds + TAB);
    if (MODE == 0) { if (tid < 257) tab[tid] = P.relb[tid * 8 + h] * LOG2E; }
#define ATT_DMA(src, off) __builtin_amdgcn_global_load_lds((const unsigned*)(src), (LAS unsigned*)(lds + (off)), 16, 0, 0)
#define ATT_LOADK(t, buf) do { ATT_DMA(ksrc + (size_t)(t) * 64 * ldk, KOFF + (buf) * KSLOT + wid * 1024); if (MODE == 1) { if (wid < 4) ATT_DMA(psrc + (size_t)(t) * 64 * 32, KOFF + (buf) * KSLOT + (8 + wid) * 1024); } } while (0)
#define ATT_LOADV(t, buf) ATT_DMA(vsrc + (size_t)(t) * 64 * ldk, VOFF + (buf) * VSLOT + wid * 1024)
    ATT_LOADK(t_first, t_first & 1);
    __syncthreads();
    float m_run = 0.f, l_run = 0.f; bool first = true;
    f32x16 o0, o1, pc0, pc1, pn0, pn1;
#pragma unroll
    for (int r = 0; r < 16; ++r) { o0[r] = 0.f; o1[r] = 0.f; pc0[r] = 0.f; pc1[r] = 0.f; pn0[r] = 0.f; pn1[r] = 0.f; }
    const int ql = (wid & 1) * 32 + r32;
    const LAS char* kb0 = lds + KOFF + hi * 1024 + r32 * 16;
    const LAS char* vp0 = lds + VOFF + ((lane >> 4) & 1) * 32 + (lane & 3) * 8 + (4 * hi + ((lane & 15) >> 2)) * 64;
#pragma unroll 2
    for (int t = t_first - 1; t <= t_last; ++t) {
        const bool ldk2 = (t + 2 <= t_last), ldv1 = (t + 1 <= t_last);
        if (ldk2) ATT_LOADK(t + 2, t & 1);
        if (ldv1) ATT_LOADV(t + 1, (t + 1) & 1);
        const bool actS = (t >= t_first) && (t >= w_lo) && (t <= cw);
        const bool actQ = (t + 1 >= w_lo) && (t + 1 <= cw);
        if (actS) {
            float rm = max3_(pc0[0], pc1[0], pc0[1]);
#pragma unroll
            for (int r = 1; r < 15; r += 2) rm = max3_(rm, pc1[r], pc0[r + 1]);
#pragma unroll
            for (int r = 2; r < 16; r += 2) rm = max3_(rm, pc1[r], pc0[r + 1 < 16 ? r + 1 : r]);
            rm = fmaxf(rm, pc1[15]);
            rm = xhalf_max(rm);
            if (first || __any(rm > THR)) {
                const float dl = first ? rm : fmaxf(rm, 0.f); m_run += dl;
#pragma unroll
                for (int r = 0; r < 16; ++r) { pc0[r] -= dl; pc1[r] -= dl; }
                if (!first) {
                    const float f = __builtin_amdgcn_exp2f(-dl); l_run *= f;
                    if (hi == 0) wsf[r32] = f;
                    LDS_WAIT();
#pragma unroll
                    for (int r = 0; r < 16; ++r) { const float fr_ = wsf[crow(r, hi)]; o0[r] *= fr_; o1[r] *= fr_; }
                }
                first = false;
            }
        }
        const LAS char* kb = kb0 + ((t + 1) & 1) * KSLOT; const LAS char* vp = vp0 + (t & 1) * VSLOT;
        const float nm = -m_run; const int dt = cw - (t + 1);
        if (actS && actQ) att_step<MODE, true, true>(kb, vp, qr, pc0, pc1, pn0, pn1, o0, o1, l_run, nm, dt, ql, hi, tab);
        else if (actS) att_step<MODE, false, true>(kb, vp, qr, pc0, pc1, pn0, pn1, o0, o1, l_run, nm, dt, ql, hi, tab);
        else if (actQ) att_step<MODE, true, false>(kb, vp, qr, pc0, pc1, pn0, pn1, o0, o1, l_run, nm, dt, ql, hi, tab);
        pc0 = pn0; pc1 = pn1;
        __syncthreads();
    }
#undef ATT_LOADK
#undef ATT_LOADV
#undef ATT_DMA
    const float lt = xhalf_sum(l_run);
    if (hi == 0) wsf[32 + r32] = lt;
    LDS_WAIT();
    LAS bf16_t* stg = (LAS bf16_t*)(lds + OST + wid * 4096);
#pragma unroll
    for (int r = 0; r < 16; ++r) { const int orow = crow(r, hi); const float rl = __builtin_amdgcn_rcpf(wsf[32 + orow]);
        stg[orow * 64 + r32] = (bf16_t)(cvt_pk_bf16(o0[r] * rl, 0.f) & 0xffffu); stg[orow * 64 + 32 + r32] = (bf16_t)(cvt_pk_bf16(o1[r] * rl, 0.f) & 0xffffu); }
    LDS_WAIT();
    const int zc = MODE ? C_BZ : C_AZ;
#pragma unroll
    for (int i = 0; i < 4; ++i) { const int row = i * 8 + (lane >> 3), ch = lane & 7; const u32x4 v = *(const LAS u32x4*)(stg + row * 64 + ch * 8);
        const size_t grow = rowbase + q0 + wid * 32 + row;
        const u32x4 z = *(const u32x4*)(P.PROJ + grow * INCP + zc + h * 64 + ch * 8); u32x4 w;
#pragma unroll
        for (int j = 0; j < 4; ++j) w[j] = cvt_pk_bf16(bf_lo(v[j]) * bf_lo(z[j]), bf_hi(v[j]) * bf_hi(z[j]));
        *(u32x4*)(P.YAB + grow * DMOD + (MODE ? 512 : 0) + h * 64 + ch * 8) = w; }
    __syncthreads();
}
}

template <int MAP>
__device__ __forceinline__ void tr_item(const float* W, int N, bf16_t* WT, int ldt, int coff, const float* gain, LAS float* scr, int item, int lane) {
    const int nblk = N / 32, kb = item / nblk, nb = item % nblk, k0 = 64 * kb, n0 = 32 * nb;
#pragma unroll 8
    for (int i = 0; i < 32; ++i) { const int kk = 2 * i + (lane >> 5); float v = W[(size_t)(k0 + kk) * N + n0 + (lane & 31)]; if (gain) v *= gain[k0 + kk]; scr[kk * 33 + (lane & 31)] = v; }
    LDS_WAIT();
    const int c = lane & 7;
#pragma unroll
    for (int j = 0; j < 4; ++j) { const int n = (lane >> 3) + 8 * j; const LAS float* s = scr + (8 * c) * 33 + n;
        u32x4 o; o.x = cvt_pk_bf16(s[0 * 33], s[1 * 33]); o.y = cvt_pk_bf16(s[2 * 33], s[3 * 33]); o.z = cvt_pk_bf16(s[4 * 33], s[5 * 33]); o.w = cvt_pk_bf16(s[6 * 33], s[7 * 33]);
        const int nn = n0 + n; const int orow = (MAP == 1) ? ((((nn & 127) < 64) ? 0 : 512) + (nn >> 7) * 64 + (nn & 63)) : ((MAP == 2) ? (nn < 2464 ? nn : nn + 96) : nn);
        if (MAP == 2) {
            unsigned w0 = 0u, w1 = 0u;
            w0 = __builtin_amdgcn_cvt_pk_fp8_f32(s[0 * 33] * 32.f, s[1 * 33] * 32.f, w0, false); w0 = __builtin_amdgcn_cvt_pk_fp8_f32(s[2 * 33] * 32.f, s[3 * 33] * 32.f, w0, true);
            w1 = __builtin_amdgcn_cvt_pk_fp8_f32(s[4 * 33] * 32.f, s[5 * 33] * 32.f, w1, false); w1 = __builtin_amdgcn_cvt_pk_fp8_f32(s[6 * 33] * 32.f, s[7 * 33] * 32.f, w1, true);
            *(u32x2*)((unsigned char*)WT + (size_t)orow * ldt + coff + k0 + 8 * c) = (u32x2){w0, w1};
        } else *(u32x4*)(WT + (size_t)orow * ldt + coff + k0 + 8 * c) = o; }
    LDS_WAIT();
}

__device__ __forceinline__ void grid_bar(unsigned* cnt, unsigned target) {
    asm volatile("s_waitcnt vmcnt(0)" ::: "memory");
    __syncthreads();
    if (threadIdx.x == 0) {
        __builtin_amdgcn_fence(__ATOMIC_RELEASE, "agent");
        asm volatile("s_waitcnt vmcnt(0)" ::: "memory");
        __hip_atomic_fetch_add(cnt, 1u, __ATOMIC_RELAXED, __HIP_MEMORY_SCOPE_AGENT);
        while (__hip_atomic_load(cnt, __ATOMIC_RELAXED, __HIP_MEMORY_SCOPE_AGENT) < target) __builtin_amdgcn_s_sleep(2);
        __builtin_amdgcn_fence(__ATOMIC_ACQUIRE, "agent");
        asm volatile("s_waitcnt vmcnt(0)" ::: "memory");
    }
    __syncthreads();
}

struct Args { const void* in[16]; float* out; unsigned char* ws; int lo, hi, sel, pad; };
constexpr int NPH = 8;
constexpr int LDS_BYTES = 135168;

__global__ void __launch_bounds__(512, 2) fwd(Args a) {
    extern __shared__ __attribute__((aligned(16))) unsigned char lds_raw[];
    LAS unsigned char* lds = (LAS unsigned char*)lds_raw;
    const int G = gridDim.x, bx = blockIdx.x;
    const int vcu = (G % 8 == 0) ? (bx % 8) * (G / 8) + bx / 8 : bx;
    const int NGW = G * 8, NGT = G * 512;
#define PH_IDS int tid = threadIdx.x; asm volatile("" : "+v"(tid)); const int lane = tid & 63, wave = __builtin_amdgcn_readfirstlane(tid >> 6); const int gw = vcu * 8 + wave, gt = bx * 512 + tid; (void)lane; (void)gw; (void)gt;
    unsigned char* ws = a.ws;
    const float* x = (const float*)a.in[0]; const int* pos = (const int*)a.in[1];
    const float* ln_in_g = (const float*)a.in[2]; const float* ln_in_b = (const float*)a.in[3];
    const float* w_in = (const float*)a.in[4]; const float* b_in = (const float*)a.in[5];
    const float* q_norm_g = (const float*)a.in[6]; const float* kv_norm_g = (const float*)a.in[7];
    const float* w_uq = (const float*)a.in[8]; const float* w_ukv = (const float*)a.in[9];
    const float* rel_bias = (const float*)a.in[10];
    const float* w_proj_a = (const float*)a.in[11]; const float* w_proj_b = (const float*)a.in[12]; const float* w_out = (const float*)a.in[13];
    const float* ln_post_g = (const float*)a.in[14]; const float* ln_post_b = (const float*)a.in[15];
    float* BIAS = (float*)(ws + WS_BIAS); float* STAT = (float*)(ws + WS_STAT); float* RS = (float*)(ws + WS_RS); float* CS = (float*)(ws + WS_CS); float* PART = (float*)(ws + WS_PART);
    bf16_t* WUQ = (bf16_t*)(ws + WS_WUQ); bf16_t* WUKV = (bf16_t*)(ws + WS_WUKV); bf16_t* WP = (bf16_t*)(ws + WS_WP); bf16_t* WOUT = (bf16_t*)(ws + WS_WOUT); bf16_t* WIN = (bf16_t*)(ws + WS_WIN);
    bf16_t* KPE = (bf16_t*)(ws + WS_KPE); bf16_t* HB = (bf16_t*)(ws + WS_HB); bf16_t* QB = (bf16_t*)(ws + WS_QB); bf16_t* KB = (bf16_t*)(ws + WS_KB); bf16_t* VB = (bf16_t*)(ws + WS_VB);
    bf16_t* MIX = (bf16_t*)(ws + WS_MIX); bf16_t* PROJ = (bf16_t*)(ws + WS_PROJ); bf16_t* YAB = (bf16_t*)a.out;
    cg::grid_group grid = cg::this_grid();
    const int lo = a.lo, hi = a.hi;
#ifndef PHMASK
#define PHMASK 0xff
#endif
#define IN(k) (((PHMASK >> (k)) & 1) && lo <= (k) && (k) < hi)
    unsigned* barw = (unsigned*)ws;
#define SEAM(k) do { if (IN(k) && IN((k) + 1)) { if ((k) == 0) grid.sync(); else grid_bar(barw, (unsigned)(k) * (unsigned)G); } } while (0)

    if (IN(0)) {
        PH_IDS
        LAS float* scr = (LAS float*)(lds + wave * 16384);
        constexpr int I_IN = 16 * 157, I_UQ = 4 * 24, I_UKV = 2 * 32, I_PA = 8 * 32, I_PB = 8 * 32, I_OUT = 16 * 32;
        constexpr int NITEMS = I_IN + I_UQ + I_UKV + I_PA + I_PB + I_OUT;
        for (int it = gw; it < NITEMS; it += NGW) {
            int r = it;
            if (r < I_IN) { tr_item<2>(w_in, INC, WIN, 1024, 0, nullptr, scr, r, lane); continue; } r -= I_IN;
            if (r < I_UQ) { tr_item<0>(w_uq, 768, WUQ, 256, 0, q_norm_g, scr, r, lane); continue; } r -= I_UQ;
            if (r < I_UKV) { tr_item<1>(w_ukv, 1024, WUKV, 256, 0, kv_norm_g, scr, r, lane); continue; } r -= I_UKV;
            if (r < I_PA) { tr_item<0>(w_proj_a, 1024, WP, 1024, 0, nullptr, scr, r, lane); continue; } r -= I_PA;
            if (r < I_PB) { tr_item<0>(w_proj_b, 1024, WP, 1024, 512, nullptr, scr, r, lane); continue; } r -= I_PB;
            tr_item<0>(w_out, 1024, WOUT, 1024, 0, nullptr, scr, r, lane);
        }
        for (int i = gt; i < 6144; i += NGT) *(u32x4*)((unsigned char*)WIN + (size_t)2464 * 1024 + (size_t)i * 16) = (u32x4){0u, 0u, 0u, 0u};
        for (int i = gt; i < 16384; i += NGT) *(u32x4*)(WUKV + (size_t)(i >> 4) * 256 + 128 + (i & 15) * 8) = (u32x4){0u, 0u, 0u, 0u};
        for (int i = gt; i < INCP; i += NGT) BIAS[i] = (i < 2464) ? b_in[i] : ((i < 2560) ? 0.f : b_in[i - 96]);
        for (int i = gt; i < NTOK * 16; i += NGT) { const int t = i >> 4, k = i & 15; const float inv = exp2f(-(float)k * 0.83048202372184058f); const float ang = (float)pos[t] * inv;
            CS[(size_t)t * 32 + k] = cosf(ang); CS[(size_t)t * 32 + 16 + k] = sinf(ang); }
        for (int m = gw; m < NTOK; m += NGW) {
            const f32x4* xr = (const f32x4*)(x + (size_t)m * DMOD) + lane; f32x4 v[4]; float s = 0.f;
#pragma unroll
            for (int j = 0; j < 4; ++j) { v[j] = xr[64 * j]; s += (v[j].x + v[j].y) + (v[j].z + v[j].w); }
            const float mean = wave_sum(s) * (1.f / DMOD); float s2 = 0.f;
#pragma unroll
            for (int j = 0; j < 4; ++j) { v[j] = v[j] - mean; s2 += (v[j].x * v[j].x + v[j].y * v[j].y) + (v[j].z * v[j].z + v[j].w * v[j].w); }
            const float rstd = 1.f / sqrtf(wave_sum(s2) * (1.f / DMOD) + LN_EPS);
            if (lane == 0) { STAT[2 * m] = mean; STAT[2 * m + 1] = rstd; }
            unsigned* o4 = (unsigned*)((unsigned char*)HB + (size_t)m * DMOD) + lane;
#pragma unroll
            for (int j = 0; j < 4; ++j) { const f32x4 gv = ((const f32x4*)ln_in_g)[lane + 64 * j], bv = ((const f32x4*)ln_in_b)[lane + 64 * j]; const f32x4 hv = v[j] * rstd * gv + bv;
                unsigned w = 0u; w = __builtin_amdgcn_cvt_pk_fp8_f32(hv.x, hv.y, w, false); w = __builtin_amdgcn_cvt_pk_fp8_f32(hv.z, hv.w, w, true); o4[64 * j] = w; }
        }
        __syncthreads();
    }
    SEAM(0);
    if (IN(1)) {
        pg8::Gemm g{HB, WIN, NTOK, INCP, 512, 512, 512}; pg8::StaticOrder S; S.init(NTOK, INCP, G, bx);
        pg8::EpiProj E{PROJ, BIAS};
        pg8::gemm_phase<pg8::EpiProj, true, true, true>(lds, g, S, E);
    }
    SEAM(1);
    if (IN(2)) {
        PH_IDS
        const int sub = lane >> 4, l16 = lane & 15;
        for (int m0 = gw * 4; m0 < NTOK; m0 += NGW * 4) {
            const int m = m0 + sub; bf16_t* pr = PROJ + (size_t)m * INCP;
            const u32x4 q0 = *((const u32x4*)(pr + C_CQ) + l16), q1 = *((const u32x4*)(pr + C_CQ) + 16 + l16);
            const u32x4 kk = *((const u32x4*)(pr + C_CKV) + l16);
            float x1 = 0.f, x2 = 0.f, cc = 0.f, ss = 0.f;
            { x1 = bf1(pr[C_KR + l16]); x2 = bf1(pr[C_KR + 16 + l16]); cc = CS[(size_t)m * 32 + l16]; ss = CS[(size_t)m * 32 + 16 + l16]; }
            float sq = 0.f, sk = 0.f;
#pragma unroll
            for (int j = 0; j < 4; ++j) { const float a0 = bf_lo(q0[j]), a1 = bf_hi(q0[j]), a2 = bf_lo(q1[j]), a3 = bf_hi(q1[j]), k0 = bf_lo(kk[j]), k1 = bf_hi(kk[j]);
                sq += (a0 * a0 + a1 * a1) + (a2 * a2 + a3 * a3); sk += k0 * k0 + k1 * k1; }
#pragma unroll
            for (int o = 1; o < 16; o <<= 1) { sq += __shfl_xor(sq, o); sk += __shfl_xor(sk, o); }
            const float rq = 1.f / sqrtf(sq * (1.f / 256.f) + RMS_EPS), rk_ = 1.f / sqrtf(sk * (1.f / 128.f) + RMS_EPS);
            u32x4 o0, o1, o2;
#pragma unroll
            for (int j = 0; j < 4; ++j) { o0[j] = cvt_pk_bf16(bf_lo(q0[j]) * rq, bf_hi(q0[j]) * rq); o1[j] = cvt_pk_bf16(bf_lo(q1[j]) * rq, bf_hi(q1[j]) * rq); o2[j] = cvt_pk_bf16(bf_lo(kk[j]) * rk_, bf_hi(kk[j]) * rk_); }
            *((u32x4*)(pr + C_CQ) + l16) = o0; *((u32x4*)(pr + C_CQ) + 16 + l16) = o1; *((u32x4*)(pr + C_CKV) + l16) = o2;
            KPE[(size_t)m * 32 + l16] = (bf16_t)(cvt_pk_bf16(x1 * cc - x2 * ss, 0.f) & 0xffffu); KPE[(size_t)m * 32 + 16 + l16] = (bf16_t)(cvt_pk_bf16(x2 * cc + x1 * ss, 0.f) & 0xffffu);
        }
    }
    SEAM(2);
    if (IN(3)) {
        { pg8::Gemm g{PROJ + C_CQ, WUQ, NTOK, 768, 256, INCP, 256}; pg8::StaticOrder S; S.init(NTOK, 768, G, bx);
          pg8::EpiQ E{QB, RS, CS}; pg8::gemm_phase<pg8::EpiQ>(lds, g, S, E); }
        { pg8::Gemm g{PROJ + C_CKV, WUKV, NTOK, 1024, 256, INCP, 256}; pg8::StaticOrder S; S.init(NTOK, 1024, G, G - 1 - bx);
          pg8::EpiKV E{KB, VB, RS}; pg8::gemm_phase<pg8::EpiKV>(lds, g, S, E); }
    }
    SEAM(3);
    if (IN(4)) {
        att::Ptrs P{PROJ, QB, KB, VB, KPE, YAB, rel_bias};
        if (a.sel & 1) for (int j = vcu; j < 1024; j += G) { const int r = j >> 8, v = j & 255, bh = v >> 3, s = v & 7; const int qb = (r == 0) ? s : (r == 1) ? 15 - s : (r == 2) ? 16 + s : 31 - s;
            att::attn_unit<1>((LAS char*)lds, bh >> 3, bh & 7, qb, P); }
        if (a.sel & 2) for (int j = vcu; j < 1024; j += G) { const int bh = j >> 5, qb = j & 31; att::attn_unit<0>((LAS char*)lds, bh >> 3, bh & 7, qb, P); }
    }
    SEAM(4);
    if (IN(5)) {
        pg8::StaticOrder S; S.init(NTOK, 1024, G, bx);
#if MIX_ONE
        { pg8::Gemm g{YAB, WP, NTOK, 1024, 1024, 1024, 1024}; pg8::EpiMix1 E{MIX, PROJ}; pg8::gemm_phase<pg8::EpiMix1>(lds, g, S, E); }
#else
        { pg8::Gemm g{YAB, WP, NTOK, 1024, 512, 1024, 1024}; pg8::EpiMix<0> E{MIX, PROJ}; pg8::gemm_phase<pg8::EpiMix<0>>(lds, g, S, E); }
        { pg8::Gemm g{YAB + 512, WP + 512, NTOK, 1024, 512, 1024, 1024}; pg8::EpiMix<1> E{MIX, PROJ}; pg8::gemm_phase<pg8::EpiMix<1>>(lds, g, S, E); }
#endif
    }
    SEAM(5);
    if (IN(6)) {
        pg8::Gemm g{MIX, WOUT, NTOK, 1024, 1024, 1024, 1024}; pg8::StaticOrder S; S.init(NTOK, 1024, G, bx);
        pg8::EpiOut E{a.out, x, STAT, ln_in_g, ln_in_b, PART}; pg8::gemm_phase<pg8::EpiOut>(lds, g, S, E);
    }
    SEAM(6);
    if (IN(7)) {
        PH_IDS
        f32x4 gv[4], bv[4];
#pragma unroll
        for (int j = 0; j < 4; ++j) { gv[j] = ((const f32x4*)ln_post_g)[lane + 64 * j]; bv[j] = ((const f32x4*)ln_post_b)[lane + 64 * j]; }
        for (int m = gw * 2; m < NTOK; m += NGW * 2) {
            f32x4* xr0 = (f32x4*)(a.out + (size_t)m * DMOD) + lane; f32x4* xr1 = xr0 + 256; f32x4 v0[4], v1[4];
#pragma unroll
            for (int j = 0; j < 4; ++j) { v0[j] = xr0[64 * j]; v1[j] = xr1[64 * j]; }
            const float pp = (lane < 32) ? PART[(size_t)m * 32 + lane] : PART[(size_t)(m + 1) * 32 + (lane - 32)];
            float e = pp;
#pragma unroll
            for (int o = 2; o < 32; o <<= 1) e += __shfl_xor(e, o);
            const float sum0 = __shfl(e, 0), sq0 = __shfl(e, 1), sum1 = __shfl(e, 32), sq1 = __shfl(e, 33);
            const float mean0 = sum0 * (1.f / DMOD), mean1 = sum1 * (1.f / DMOD);
            const float rstd0 = 1.f / sqrtf(fmaxf(sq0 * (1.f / DMOD) - mean0 * mean0, 0.f) + LN_EPS), rstd1 = 1.f / sqrtf(fmaxf(sq1 * (1.f / DMOD) - mean1 * mean1, 0.f) + LN_EPS);
#pragma unroll
            for (int j = 0; j < 4; ++j) { xr0[64 * j] = (v0[j] - mean0) * rstd0 * gv[j] + bv[j]; xr1[64 * j] = (v1[j] - mean1) * rstd1 * gv[j] + bv[j]; }
        }
    }
#undef IN
#undef SEAM
}

extern "C" void kernel_launch(void* const* d_in, const int* in_sizes, int n_in, void* d_out, int out_size, void* d_ws, size_t ws_size, hipStream_t stream) {
    static int grid = 0;
    if (grid == 0) {
        if (n_in != 16 || out_size != NTOK * DMOD || ws_size < WS_END) { fprintf(stderr, "kernel_launch: unexpected shapes (n_in %d, out %d, ws %zu)\n", n_in, out_size, ws_size); grid = -1; return; }
        int dev = 0, cus = 0, per_cu = 0;
        hipGetDevice(&dev); hipDeviceGetAttribute(&cus, hipDeviceAttributeMultiprocessorCount, dev);
        hipFuncSetAttribute((const void*)fwd, hipFuncAttributeMaxDynamicSharedMemorySize, LDS_BYTES);
        hipOccupancyMaxActiveBlocksPerMultiprocessor(&per_cu, (const void*)fwd, 512, LDS_BYTES);
        (void)hipGetLastError();
        if (per_cu < 1) per_cu = 1;
        grid = cus;
        if (grid > cus * per_cu) grid = cus * per_cu;
    }
    if (grid < 0) return;
    hipMemsetAsync(d_ws, 0, 4096, stream);
    Args a{};
    for (int i = 0; i < 16; ++i) a.in[i] = d_in[i];
    a.out = (float*)d_out; a.ws = (unsigned char*)d_ws;
    a.sel = 3;
#if defined(PROBE_PHASE)
    { Args pa = a; pa.lo = PROBE_PHASE; pa.hi = PROBE_PHASE + 1; pa.sel = PROBE_SEL; hipLaunchKernelGGL(fwd, dim3(grid), dim3(512), LDS_BYTES, stream, pa); }
#endif
#if ONE_LAUNCH
    a.lo = 0; a.hi = NPH;
    void* args[] = {&a};
    hipError_t e = hipLaunchCooperativeKernel((const void*)fwd, dim3(grid), dim3(512), args, LDS_BYTES, stream);
    if (e != hipSuccess) fprintf(stderr, "cooperative launch failed: %s (grid %d)\n", hipGetErrorString(e), grid);
#else
    for (int p = 0; p < NPH; ++p) { a.lo = p; a.hi = p + 1; hipLaunchKernelGGL(fwd, dim3(grid), dim3(512), LDS_BYTES, stream, a); }
#endif
}
```
